# Optimizing an MI355X kernel written in HIP

```python
import math
import jax, jax.numpy as jnp
from jax import lax
import numpy as np

D_MODEL = 1024
BATCH = 8
SEQ = 2048
DEPTH = 4

NSA_HEADS = 8
NSA_KV_HEADS = 2
NSA_GROUP = NSA_HEADS // NSA_KV_HEADS
HEAD_DIM = 64
ROPE_DIMS = HEAD_DIM // 4
ROPE_THETA = 500000.0
CMP_BLOCK = 32
CMP_STRIDE = 16
CMP_HIDDEN = 2 * HEAD_DIM
SLC_BLOCK = 64
SLC_TOPK = 16
WINDOW = 512
Q_BLOCK = 128
SLC_Q_CHUNK = 32
NSA_WIDTH = NSA_HEADS * HEAD_DIM
KV_WIDTH = NSA_KV_HEADS * HEAD_DIM
S5_WIDTH = 256
S5_GROUP_CH = 16
S5_GROUPS = S5_WIDTH // S5_GROUP_CH
S5_STATE = 64
N_BRANCHES = 2
N_EXPERT_GROUPS = 4
EXPERTS_PER_GROUP = 8
N_EXPERTS = N_EXPERT_GROUPS * EXPERTS_PER_GROUP
EXPERT_TOP_K = 2
EXPERT_FF = 512
MOE_BLOCK = 128
RMS_EPS = 1e-6
NEG_BIG = -1e30
IN_COLS = NSA_WIDTH + 6 * KV_WIDTH + 3 * NSA_HEADS + S5_WIDTH + N_BRANCHES * D_MODEL

kernel_name = 'hybrid_nsa_s5_hiermoe_trunk'


def rmsnorm(x, gain):
    xf = x.astype(jnp.float32)
    xf = xf * lax.rsqrt(jnp.mean(xf * xf, axis=-1, keepdims=True) + RMS_EPS)
    return xf.astype(x.dtype) * gain


def rope_partial(x, pos):
    inv_freq = ROPE_THETA ** (-jnp.arange(0, ROPE_DIMS, 2, dtype=jnp.float32) / ROPE_DIMS)
    ang = pos.astype(jnp.float32)[..., None] * inv_freq
    cos = jnp.cos(ang).astype(x.dtype)
    sin = jnp.sin(ang).astype(x.dtype)
    half = ROPE_DIMS // 2
    x1 = x[..., :half]
    x2 = x[..., half:ROPE_DIMS]
    return jnp.concatenate([x1 * cos - x2 * sin, x2 * cos + x1 * sin, x[..., ROPE_DIMS:]], axis=-1)


def masked_softmax(s, mask):
    s = jnp.where(mask, s.astype(jnp.float32), NEG_BIG)
    return jnp.where(mask, jax.nn.softmax(s, axis=-1), 0.0)


def nsa_mixer(q, k_cmp, v_cmp, k_slc, v_slc, k_win, v_win, gate_logits, positions,
              q_gain, k_gain, ck_pos, ck_w1, ck_w2, cv_pos, cv_w1, cv_w2):
    B, S, _ = q.shape
    Hkv, G, dh = NSA_KV_HEADS, NSA_GROUP, HEAD_DIM
    scale = dh ** -0.5
    t_idx = jnp.arange(S)

    def heads(t, n):
        return t.reshape(B, S, n, dh).transpose(0, 2, 1, 3)

    pos = positions[:, None, :]
    qh = rope_partial(rmsnorm(heads(q, NSA_HEADS), q_gain), pos).reshape(B, Hkv, G, S, dh)

    n_cmp = (S - CMP_BLOCK) // CMP_STRIDE + 1
    blk_idx = np.arange(n_cmp)[:, None] * CMP_STRIDE + np.arange(CMP_BLOCK)[None, :]

    def compress(t, pos_emb, w1, w2):
        blocks = heads(t, Hkv)[:, :, blk_idx] + pos_emb
        flat = blocks.reshape(B, Hkv, n_cmp, CMP_BLOCK * dh)
        return jax.nn.gelu(flat @ w1) @ w2

    cmp_end = blk_idx[:, -1]
    kc = rope_partial(rmsnorm(compress(k_cmp, ck_pos, ck_w1, ck_w2), k_gain), positions[:, cmp_end][:, None, :])
    vc = compress(v_cmp, cv_pos, cv_w1, cv_w2)
    s_c = jnp.einsum('bhgsd,bhcd->bhgsc', qh, kc) * scale
    mask_c = jnp.asarray(cmp_end)[None, :] <= t_idx[:, None]
    p_c = masked_softmax(s_c, mask_c)
    o_c = jnp.einsum('bhgsc,bhcd->bhgsd', p_c.astype(vc.dtype), vc)

    n_slc = S // SLC_BLOCK
    top_k = min(SLC_TOPK, n_slc)
    cmp_start = np.arange(n_cmp) * CMP_STRIDE
    slc_start = np.arange(n_slc) * SLC_BLOCK
    overlap = ((cmp_start[:, None] < slc_start[None, :] + SLC_BLOCK)
               & (cmp_start[:, None] + CMP_BLOCK > slc_start[None, :])).astype(np.float32)
    imp = jnp.einsum('bhgsc,cn->bhsn', p_c, jnp.asarray(overlap))
    j = jnp.arange(n_slc)[None, :]
    cur = (t_idx // SLC_BLOCK)[:, None]
    forced = (j == 0) | (j == cur) | (j == cur - 1)
    imp = jnp.where(forced, jnp.inf, jnp.where(j > cur, -jnp.inf, imp))
    _, sel = lax.top_k(imp, top_k)

    ks_blk = rope_partial(rmsnorm(heads(k_slc, Hkv), k_gain), pos).reshape(B, Hkv, n_slc, SLC_BLOCK, dh)
    vs_blk = heads(v_slc, Hkv).reshape(B, Hkv, n_slc, SLC_BLOCK, dh)
    n_chunk = S // SLC_Q_CHUNK
    q_ch = qh.reshape(B, Hkv, G, n_chunk, SLC_Q_CHUNK, dh).transpose(3, 0, 1, 2, 4, 5)
    sel_ch = sel.reshape(B, Hkv, n_chunk, SLC_Q_CHUNK, top_k).transpose(2, 0, 1, 3, 4)
    t_ch = t_idx.reshape(n_chunk, SLC_Q_CHUNK)
    b_ix = jnp.arange(B)[:, None, None, None]
    h_ix = jnp.arange(Hkv)[None, :, None, None]

    def slc_chunk(args):
        qc, sc, tc = args
        kg = ks_blk[b_ix, h_ix, sc]
        vg = vs_blk[b_ix, h_ix, sc]
        C = tc.shape[0]
        s = jnp.einsum('bhgqd,bhqnkd->bhgqnk', qc, kg).reshape(B, Hkv, G, C, top_k * SLC_BLOCK) * scale
        key_pos = sc[..., None] * SLC_BLOCK + jnp.arange(SLC_BLOCK)
        mask = (key_pos <= tc[None, None, :, None, None]).reshape(B, Hkv, 1, C, top_k * SLC_BLOCK)
        p = masked_softmax(s, mask)
        return jnp.einsum('bhgqm,bhqmd->bhgqd', p.astype(vg.dtype), vg.reshape(B, Hkv, C, top_k * SLC_BLOCK, dh))

    o_s = lax.map(slc_chunk, (q_ch, sel_ch, t_ch))
    o_s = o_s.transpose(1, 2, 3, 0, 4, 5).reshape(B, Hkv, G, S, dh)

    nb = S // Q_BLOCK
    n_prev = WINDOW // Q_BLOCK

    def windows(t):
        tb = jnp.pad(t.reshape(B, Hkv, nb, Q_BLOCK, dh), ((0, 0), (0, 0), (n_prev, 0), (0, 0), (0, 0)))
        return jnp.concatenate([tb[:, :, i:i + nb] for i in range(n_prev + 1)], axis=3)

    kw = windows(rope_partial(rmsnorm(heads(k_win, Hkv), k_gain), pos))
    vw = windows(heads(v_win, Hkv))
    qw = qh.reshape(B, Hkv, G, nb, Q_BLOCK, dh)
    s_w = jnp.einsum('bhgnqd,bhnkd->bhgnqk', qw, kw) * scale
    q_pos = jnp.arange(nb)[:, None] * Q_BLOCK + jnp.arange(Q_BLOCK)[None, :]
    k_pos = (jnp.arange(nb)[:, None] - n_prev) * Q_BLOCK + jnp.arange((n_prev + 1) * Q_BLOCK)[None, :]
    diff = q_pos[:, :, None] - k_pos[:, None, :]
    mask_w = (diff >= 0) & (diff < WINDOW) & (k_pos[:, None, :] >= 0)
    p_w = masked_softmax(s_w, mask_w)
    o_w = jnp.einsum('bhgnqk,bhnkd->bhgnqd', p_w.astype(vw.dtype), vw).reshape(B, Hkv, G, S, dh)

    g = jax.nn.sigmoid(gate_logits.reshape(B, S, NSA_HEADS, 3).transpose(0, 2, 1, 3)).reshape(B, Hkv, G, S, 3)
    o = g[..., 0:1] * o_c + g[..., 1:2] * o_s + g[..., 2:3] * o_w
    return o.transpose(0, 3, 1, 2, 4).reshape(B, S, NSA_WIDTH)


def s5_mixer(u, a_re, a_im, log_dt, b_re, b_im, c_re, c_im, d_skip, w_glu):
    B, S, _ = u.shape
    f32 = jnp.float32
    lam_re = jnp.minimum(a_re.astype(f32), -1e-4)
    lam_im = a_im.astype(f32)
    dt = jnp.exp(log_dt.astype(f32))[:, None]
    mag = jnp.exp(lam_re * dt)
    ang = lam_im * dt
    lb_re = mag * jnp.cos(ang)
    lb_im = mag * jnp.sin(ang)
    den = lam_re * lam_re + lam_im * lam_im
    f_re = ((lb_re - 1.0) * lam_re + lb_im * lam_im) / den
    f_im = (lb_im * lam_re - (lb_re - 1.0) * lam_im) / den
    br = b_re.astype(f32)
    bi = b_im.astype(f32)
    bb_re = f_re[..., None] * br - f_im[..., None] * bi
    bb_im = f_re[..., None] * bi + f_im[..., None] * br
    ug = u.astype(f32).reshape(B, S, S5_GROUPS, S5_GROUP_CH)
    bu_re = jnp.einsum('bsgc,gpc->sbgp', ug, bb_re)
    bu_im = jnp.einsum('bsgc,gpc->sbgp', ug, bb_im)
    a_re_t = jnp.broadcast_to(lb_re, bu_re.shape)
    a_im_t = jnp.broadcast_to(lb_im, bu_im.shape)

    def combine(left, right):
        ar1, ai1, br1, bi1 = left
        ar2, ai2, br2, bi2 = right
        return (ar2 * ar1 - ai2 * ai1, ar2 * ai1 + ai2 * ar1,
                ar2 * br1 - ai2 * bi1 + br2, ar2 * bi1 + ai2 * br1 + bi2)

    _, _, x_re, x_im = lax.associative_scan(combine, (a_re_t, a_im_t, bu_re, bu_im), axis=0)
    y = (jnp.einsum('sbgp,gcp->bsgc', x_re, c_re.astype(f32))
         - jnp.einsum('sbgp,gcp->bsgc', x_im, c_im.astype(f32))).reshape(B, S, S5_WIDTH)
    y = y + d_skip.astype(f32) * ug.reshape(B, S, S5_WIDTH)
    y = jax.nn.gelu(y).astype(u.dtype)
    z = y @ w_glu
    return z[..., :S5_WIDTH] * jax.nn.sigmoid(z[..., S5_WIDTH:])


def hier_moe(h, w_rg, b_rg, w_re, b_re, w_gate, w_up, w_down):
    B, S, D = h.shape
    N = B * S
    ht = h.reshape(N, D)
    g_logits = (ht @ w_rg + b_rg).astype(jnp.float32)
    g_sel = jnp.argmax(g_logits, axis=-1)
    g_w = jnp.take_along_axis(jax.nn.softmax(g_logits, axis=-1), g_sel[:, None], axis=1)
    e_logits = (ht @ w_re + b_re).astype(jnp.float32).reshape(N, N_EXPERT_GROUPS, EXPERTS_PER_GROUP)
    e_logits = jnp.take_along_axis(e_logits, g_sel[:, None, None], axis=1)[:, 0]
    top_p, top_i = lax.top_k(jax.nn.softmax(e_logits, axis=-1), EXPERT_TOP_K)
    w = g_w * top_p / jnp.sum(top_p, axis=-1, keepdims=True)
    expert = g_sel[:, None].astype(jnp.int32) * EXPERTS_PER_GROUP + top_i

    A = N * EXPERT_TOP_K
    e_flat = expert.reshape(A)
    tok = jnp.repeat(jnp.arange(N, dtype=jnp.int32), EXPERT_TOP_K)
    order = jnp.argsort(e_flat)
    e_sorted = e_flat[order]
    tok_sorted = tok[order]
    w_sorted = w.reshape(A)[order]
    counts = jnp.zeros((N_EXPERTS,), jnp.int32).at[e_flat].add(1)
    starts = jnp.cumsum(counts) - counts
    padded = (counts + MOE_BLOCK - 1) // MOE_BLOCK * MOE_BLOCK
    pends = jnp.cumsum(padded)
    pstarts = pends - padded
    dest = pstarts[e_sorted] + (jnp.arange(A, dtype=jnp.int32) - starts[e_sorted])
    cap = A + N_EXPERTS * MOE_BLOCK
    n_blk = cap // MOE_BLOCK
    buf = jnp.zeros((cap, D), h.dtype).at[dest].set(ht[tok_sorted])
    blk_expert = jnp.minimum(jnp.searchsorted(pends, jnp.arange(n_blk) * MOE_BLOCK, side='right'), N_EXPERTS - 1)

    def expert_block(args):
        xb, e = args
        return (jax.nn.silu(xb @ w_gate[e]) * (xb @ w_up[e])) @ w_down[e]

    out_buf = lax.map(expert_block, (buf.reshape(n_blk, MOE_BLOCK, D), blk_expert)).reshape(cap, D)
    y_a = out_buf[dest] * w_sorted[:, None].astype(h.dtype)
    return jax.ops.segment_sum(y_a, tok_sorted, num_segments=N).reshape(B, S, D)


def setup_inputs(seed: int = 0) -> dict:
    key = jax.random.key(seed)
    keys = iter(jax.random.split(key, 48))
    f32 = jnp.float32
    L = DEPTH

    def nrm(shape, scale):
        return jax.random.normal(next(keys), shape, f32) * scale

    res_scale = (2.0 * DEPTH) ** -0.5
    x = nrm((BATCH, SEQ, D_MODEL), 1.0)
    start = jax.random.randint(next(keys), (BATCH, 1), 0, 4096, dtype=jnp.int32)
    positions = start + jnp.arange(SEQ, dtype=jnp.int32)[None, :]
    n_idx = jnp.arange(S5_STATE, dtype=f32)
    return {
        'x': x,
        'positions': positions,
        'norm_mix': 1.0 + nrm((L, D_MODEL), 0.02),
        'norm_ffn': 1.0 + nrm((L, D_MODEL), 0.02),
        'w_in': nrm((L, D_MODEL, IN_COLS), D_MODEL ** -0.5),
        'q_gain': 1.0 + nrm((L, HEAD_DIM), 0.02),
        'k_gain': 1.0 + nrm((L, HEAD_DIM), 0.02),
        'cmp_k_pos': nrm((L, CMP_BLOCK, HEAD_DIM), 0.1),
        'cmp_k_w1': nrm((L, CMP_BLOCK * HEAD_DIM, CMP_HIDDEN), (CMP_BLOCK * HEAD_DIM) ** -0.5),
        'cmp_k_w2': nrm((L, CMP_HIDDEN, HEAD_DIM), CMP_HIDDEN ** -0.5),
        'cmp_v_pos': nrm((L, CMP_BLOCK, HEAD_DIM), 0.1),
        'cmp_v_w1': nrm((L, CMP_BLOCK * HEAD_DIM, CMP_HIDDEN), (CMP_BLOCK * HEAD_DIM) ** -0.5),
        'cmp_v_w2': nrm((L, CMP_HIDDEN, HEAD_DIM), CMP_HIDDEN ** -0.5),
        's5_a_re': -0.5 + nrm((L, S5_GROUPS, S5_STATE), 0.01),
        's5_a_im': math.pi * n_idx + nrm((L, S5_GROUPS, S5_STATE), 0.01),
        's5_log_dt': jax.random.uniform(next(keys), (L, S5_GROUPS), f32, math.log(1e-3), math.log(1e-1)),
        's5_b_re': nrm((L, S5_GROUPS, S5_STATE, S5_GROUP_CH), (2.0 * S5_GROUP_CH) ** -0.5),
        's5_b_im': nrm((L, S5_GROUPS, S5_STATE, S5_GROUP_CH), (2.0 * S5_GROUP_CH) ** -0.5),
        's5_c_re': nrm((L, S5_GROUPS, S5_GROUP_CH, S5_STATE), (2.0 * S5_STATE) ** -0.5),
        's5_c_im': nrm((L, S5_GROUPS, S5_GROUP_CH, S5_STATE), (2.0 * S5_STATE) ** -0.5),
        's5_d': nrm((L, S5_WIDTH), 0.5),
        's5_glu': nrm((L, S5_WIDTH, 2 * S5_WIDTH), S5_WIDTH ** -0.5),
        'proj_nsa': nrm((L, NSA_WIDTH, D_MODEL), NSA_WIDTH ** -0.5),
        'proj_s5': nrm((L, S5_WIDTH, D_MODEL), S5_WIDTH ** -0.5),
        'w_out': nrm((L, D_MODEL, D_MODEL), D_MODEL ** -0.5 * res_scale),
        'router_group': nrm((L, D_MODEL, N_EXPERT_GROUPS), D_MODEL ** -0.5),
        'router_group_bias': nrm((L, N_EXPERT_GROUPS), 0.01),
        'router_expert': nrm((L, D_MODEL, N_EXPERTS), D_MODEL ** -0.5),
        'router_expert_bias': nrm((L, N_EXPERTS), 0.01),
        'expert_gate': nrm((L, N_EXPERTS, D_MODEL, EXPERT_FF), D_MODEL ** -0.5),
        'expert_up': nrm((L, N_EXPERTS, D_MODEL, EXPERT_FF), D_MODEL ** -0.5),
        'expert_down': nrm((L, N_EXPERTS, EXPERT_FF, D_MODEL), EXPERT_FF ** -0.5 * res_scale),
    }


def reference(x, positions, norm_mix, norm_ffn, w_in, q_gain, k_gain,
              cmp_k_pos, cmp_k_w1, cmp_k_w2, cmp_v_pos, cmp_v_w1, cmp_v_w2,
              s5_a_re, s5_a_im, s5_log_dt, s5_b_re, s5_b_im, s5_c_re, s5_c_im, s5_d, s5_glu,
              proj_nsa, proj_s5, w_out, router_group, router_group_bias, router_expert,
              router_expert_bias, expert_gate, expert_up, expert_down):
    sizes = (NSA_WIDTH, KV_WIDTH, KV_WIDTH, KV_WIDTH, KV_WIDTH, KV_WIDTH, KV_WIDTH,
             3 * NSA_HEADS, S5_WIDTH, D_MODEL, D_MODEL)
    split_at = np.cumsum(sizes)[:-1].tolist()
    for l in range(DEPTH):
        h = rmsnorm(x, norm_mix[l])
        z = h @ w_in[l]
        q, kc, vc, ks, vs, kw, vw, nsa_g, u, g_a, g_s = jnp.split(z, split_at, axis=-1)
        o_a = nsa_mixer(q, kc, vc, ks, vs, kw, vw, nsa_g, positions, q_gain[l], k_gain[l],
                        cmp_k_pos[l], cmp_k_w1[l], cmp_k_w2[l], cmp_v_pos[l], cmp_v_w1[l], cmp_v_w2[l])
        o_b = s5_mixer(u, s5_a_re[l], s5_a_im[l], s5_log_dt[l], s5_b_re[l], s5_b_im[l],
                       s5_c_re[l], s5_c_im[l], s5_d[l], s5_glu[l])
        merged = jax.nn.sigmoid(g_a) * (o_a @ proj_nsa[l]) + jax.nn.sigmoid(g_s) * (o_b @ proj_s5[l])
        x = x + merged @ w_out[l]
        x = x + hier_moe(rmsnorm(x, norm_ffn[l]), router_group[l], router_group_bias[l],
                         router_expert[l], router_expert_bias[l],
                         expert_gate[l], expert_up[l], expert_down[l])
    return x
```

```cpp
#include <hip/hip_runtime.h>
#include <cstdint>
#include <cstdio>

#ifndef MK_SPLIT
#define MK_SPLIT 1
#endif

#define DEVFI __device__ __forceinline__
#define LAS __attribute__((address_space(3)))
typedef unsigned short bf16_t;
typedef short bf16x8 __attribute__((ext_vector_type(8)));
typedef float f32x4 __attribute__((ext_vector_type(4)));

constexpr int D = 1024, BATCH = 8, SEQ = 2048, NTOK = BATCH * SEQ, DEPTH = 4;
constexpr int NH = 8, NKV = 2, HD = 64;
constexpr int NCMP = 127;
constexpr int IN_COLS = 3608, ZN = 3840;
constexpr int ZC_Q = 0, ZC_KC = 512, ZC_VC = 640, ZC_KS = 768, ZC_VS = 896, ZC_KW = 1024, ZC_VW = 1152, ZC_U = 1280, ZC_GA = 1536, ZC_GS = 2560, ZC_NG = 3584;
constexpr int SC_NG = 1280, SC_U = 1304, SC_GA = 1560, SC_GS = 2584;
constexpr int NEXP = 32, FF = 512;
constexpr int A_PAD = NTOK * 2 + NEXP * 256;
constexpr float RMS_EPS = 1e-6f;

constexpr size_t al256(size_t x) { return (x + 255) & ~(size_t)255; }
constexpr size_t CTL_BYTES = 65536;
constexpr size_t CTL_CNT = 16384;
constexpr size_t WS_ROPE = CTL_BYTES;
constexpr size_t WS_S5LB = al256(WS_ROPE + (size_t)NTOK * 16 * 4);
constexpr size_t WS_S5BB = al256(WS_S5LB + (size_t)DEPTH * 16 * 64 * 2 * 4);
constexpr size_t WS_CB1 = al256(WS_S5BB + (size_t)DEPTH * 16 * 64 * 16 * 2 * 4);
constexpr size_t WS_WIN = al256(WS_CB1 + (size_t)DEPTH * 2 * 128 * 4);
constexpr size_t WS_CW1 = al256(WS_WIN + (size_t)DEPTH * ZN * 1024 * 2);
constexpr size_t WS_GLU = al256(WS_CW1 + (size_t)DEPTH * 2 * 128 * 2048 * 2);
constexpr size_t WS_PA = al256(WS_GLU + (size_t)DEPTH * 512 * 256 * 2);
constexpr size_t WS_PS = al256(WS_PA + (size_t)DEPTH * 1024 * 512 * 2);
constexpr size_t WS_WO = al256(WS_PS + (size_t)DEPTH * 1024 * 256 * 2);
constexpr size_t WS_EG = al256(WS_WO + (size_t)DEPTH * 1024 * 1024 * 2);
constexpr size_t WS_EU = al256(WS_EG + (size_t)DEPTH * 32 * 512 * 1024 * 2);
constexpr size_t WS_ED = al256(WS_EU + (size_t)DEPTH * 32 * 512 * 1024 * 2);
constexpr size_t WS_H = al256(WS_ED + (size_t)DEPTH * 32 * 1024 * 512 * 2);
constexpr size_t WS_Z = al256(WS_H + (size_t)NTOK * 1024 * 2);
constexpr size_t WS_HID = al256(WS_Z + (size_t)NTOK * ZN * 2);
constexpr size_t WS_KC = al256(WS_HID + (size_t)2 * 2048 * 128 * 2);
constexpr size_t WS_VC = al256(WS_KC + (size_t)BATCH * 2 * 128 * 64 * 4);
constexpr size_t WS_YB = al256(WS_VC + (size_t)BATCH * 2 * 128 * 64 * 4);
constexpr size_t WS_OB = al256(WS_YB + (size_t)NTOK * 256 * 2);
constexpr size_t WS_OA = al256(WS_OB + (size_t)NTOK * 256 * 2);
constexpr size_t WS_OCMP = al256(WS_OA + (size_t)NTOK * 512 * 2);
constexpr size_t WS_SC = al256(WS_OCMP + (size_t)NTOK * 512 * 4);
constexpr size_t WS_PCS = al256(WS_SC + (size_t)BATCH * 2 * SEQ * 128 * 4);
constexpr size_t WS_IMP = al256(WS_PCS + (size_t)BATCH * 2 * SEQ * 128 * 4);
constexpr size_t WS_SEL = al256(WS_IMP + (size_t)BATCH * 2 * SEQ * 32 * 4);
constexpr size_t WS_EID = al256(WS_SEL + (size_t)BATCH * 2 * SEQ * 4);
constexpr size_t WS_EW = al256(WS_EID + (size_t)NTOK * 2 * 4);
constexpr size_t WS_EPOS = al256(WS_EW + (size_t)NTOK * 2 * 4);
constexpr size_t WS_LIST = al256(WS_EPOS + (size_t)NTOK * 2 * 4);
constexpr size_t WS_MRG = al256(WS_LIST + (size_t)32 * NTOK * 4);
constexpr size_t WS_ACT = al256(WS_MRG + (size_t)NTOK * 1024 * 2);
constexpr size_t WS_Y = al256(WS_ACT + (size_t)A_PAD * 512 * 2);
constexpr size_t WS_S5X = WS_MRG;
constexpr size_t WS_END = al256(WS_Y + (size_t)A_PAD * 1024 * 2);
static_assert(WS_S5X + (size_t)NTOK * 16 * 128 * 4 <= WS_END, "S5X alias must fit");

constexpr int LDS_STAGE = 131072;
constexpr int LDS_CTL = LDS_STAGE;
constexpr int LDS_BYTES = LDS_STAGE + 256;

constexpr int NST = 11;
constexpr int NPHASE = 1 + DEPTH * NST + 1;

struct Params {
    const void* in[32];
    float* out;
    unsigned char* ws;
    int ph_lo, ph_hi;
};
typedef const __attribute__((address_space(4))) Params* KP;

DEVFI int opaque_tid() { int t = threadIdx.x; asm volatile("" : "+v"(t)); return t; }
DEVFI float opaque_zero() { float z = 0.f; asm volatile("" : "+v"(z)); return z; }
DEVFI float bf2f(bf16_t v) { return __uint_as_float((unsigned)v << 16); }
DEVFI unsigned f2bf(float f) { unsigned u = __float_as_uint(f); return (u + 0x7fffu + ((u >> 16) & 1u)) >> 16; }
DEVFI unsigned pk2(float lo, float hi) { return f2bf(lo) | (f2bf(hi) << 16); }
DEVFI float wave_sum(float v) {
#pragma unroll
    for (int o = 1; o < 64; o <<= 1) v += __shfl_xor(v, o);
    return v;
}
DEVFI float sigmoidf_(float x) { return 1.f / (1.f + __expf(-x)); }
DEVFI float gelu_tanh(float x) { return 0.5f * x * (1.f + tanhf(0.7978845608028654f * (x + 0.044715f * x * x * x))); }
DEVFI void unpack8(uint4 v, float* f) {
    f[0] = __uint_as_float(v.x << 16); f[1] = __uint_as_float(v.x & 0xffff0000u);
    f[2] = __uint_as_float(v.y << 16); f[3] = __uint_as_float(v.y & 0xffff0000u);
    f[4] = __uint_as_float(v.z << 16); f[5] = __uint_as_float(v.z & 0xffff0000u);
    f[6] = __uint_as_float(v.w << 16); f[7] = __uint_as_float(v.w & 0xffff0000u);
}

#define XB_TMO      128
#define XB_XCNT(j)  (256  + 64 * (j))
#define XB_XSUB(j)  (1280 + 64 * (j))
#define XB_XGEN(j)  (2304 + 64 * (j))
#define XB_TOP      3328
#define XB_TOPGEN   3392
#define XCD_BAR_WORDS 3456
#define XB_SPIN_CAP (1u << 22)
DEVFI unsigned xb_ld(unsigned* p) { return __hip_atomic_load(p, __ATOMIC_RELAXED, __HIP_MEMORY_SCOPE_AGENT); }
DEVFI unsigned xb_add(unsigned* p, unsigned v) { return __hip_atomic_fetch_add(p, v, __ATOMIC_RELAXED, __HIP_MEMORY_SCOPE_AGENT); }
DEVFI unsigned xb_xcc_id() { return (unsigned)__builtin_amdgcn_s_getreg((3 << 11) | 20) & 0xFu; }
#define XB_SPIN(cond, bar) do { unsigned _sp = 0; while (cond) { __builtin_amdgcn_s_sleep(1); \
    if ((++_sp & 255u) == 0u) { if (xb_ld(&(bar)[XB_TMO])) break; if (_sp > XB_SPIN_CAP) { atomicAdd(&(bar)[XB_TMO], 1u); break; } } } } while (0)
struct XcdBarrier { unsigned* bar; unsigned x; volatile LAS unsigned* st; };
DEVFI XcdBarrier xcd_barrier_post(unsigned* bar, volatile LAS unsigned* st) {
    XcdBarrier b; b.bar = bar; b.x = xb_xcc_id(); b.st = st;
    if (threadIdx.x == 0) (void)xb_add(&bar[XB_XCNT(b.x)], 1u);
    return b;
}
DEVFI void xcd_barrier_complete(unsigned* bar, unsigned x, unsigned& nloc, unsigned& nx) {
    const unsigned G = gridDim.x * gridDim.y * gridDim.z;
    unsigned sum, cnt, mine, sp = 0u;
    for (;;) {
        sum = 0u; cnt = 0u; mine = 0u;
#pragma unroll
        for (unsigned j = 0; j < 16; ++j) { const unsigned c = xb_ld(&bar[XB_XCNT(j)]); sum += c; cnt += (c > 0u) ? 1u : 0u; mine = (j == x) ? c : mine; }
        if (sum == G) break;
        __builtin_amdgcn_s_sleep(1);
        if ((++sp & 255u) == 0u) { if (xb_ld(&bar[XB_TMO])) break; if (sp > XB_SPIN_CAP) { atomicAdd(&bar[XB_TMO], 1u); break; } }
    }
    nloc = mine > 0u ? mine : 1u; nx = cnt > 0u ? cnt : 1u;
}
DEVFI void xcd_barrier(const XcdBarrier& b) {
    asm volatile("s_waitcnt vmcnt(0)" ::: "memory");
    __syncthreads();
    if (threadIdx.x == 0) {
        unsigned* bar = b.bar;
        __builtin_amdgcn_s_waitcnt(0);
        unsigned nloc = b.st[0], nx = b.st[1];
        if (nloc == 0u) { xcd_barrier_complete(bar, b.x, nloc, nx); b.st[0] = nloc; b.st[1] = nx; }
        const unsigned old = xb_add(&bar[XB_XSUB(b.x)], 1u);
        const unsigned gen = old / nloc;
        if (old + 1u == (gen + 1u) * nloc) {
            __builtin_amdgcn_fence(__ATOMIC_RELEASE, "agent");
            asm volatile("s_waitcnt vmcnt(0)" ::: "memory");
            const unsigned og = xb_add(&bar[XB_TOP], 1u);
            const unsigned tg = og / nx;
            if (og + 1u == (tg + 1u) * nx) xb_add(&bar[XB_TOPGEN], 1u);
            else XB_SPIN(xb_ld(&bar[XB_TOPGEN]) == tg, bar);
            __builtin_amdgcn_fence(__ATOMIC_ACQUIRE, "agent");
            xb_add(&bar[XB_XGEN(b.x)], 1u);
            asm volatile("s_waitcnt vmcnt(0)" ::: "memory");
        } else {
            XB_SPIN(xb_ld(&bar[XB_XGEN(b.x)]) == gen, bar);
            __builtin_amdgcn_fence(__ATOMIC_ACQUIRE, "agent");
            asm volatile("s_waitcnt vmcnt(0)" ::: "memory");
        }
    }
    __syncthreads();
}

DEVFI void glds16(const bf16_t* g, unsigned char* l) {
    __builtin_amdgcn_global_load_lds((const unsigned*)g, (unsigned*)l, 16, 0, 0);
}
template <int NB>
DEVFI void gemm_tile(unsigned char* lds, const bf16_t* a0, const bf16_t* a1, int a_kstride,
                     const bf16_t* b0, const bf16_t* b1, int nk, f32x4 (&acc)[NB][4][4]) {
    const int tid = opaque_tid(), lane = tid & 63, wid = tid >> 6;
    const int wr = wid >> 1, wc = wid & 1, fr = lane & 15, fq = lane >> 4;
    constexpr int STAGE = 32768 + NB * 16384;
    const float fz = opaque_zero();
#pragma unroll
    for (int b = 0; b < NB; ++b)
#pragma unroll
        for (int m = 0; m < 4; ++m)
#pragma unroll
            for (int n = 0; n < 4; ++n) acc[b][m][n] = (f32x4){fz, fz, fz, fz};
    auto stage = [&](int kt, int buf) {
        unsigned char* s = lds + buf * STAGE + tid * 16;
        const bf16_t* pa0 = a0 + (size_t)kt * a_kstride;
        const bf16_t* pa1 = a1 + (size_t)kt * a_kstride;
#pragma unroll
        for (int p = 0; p < 2; ++p) {
            glds16(pa0 + p * 32, s + p * 16384);
            glds16(pa1 + p * 32, s + p * 16384 + 8192);
            glds16(b0 + kt * 64 + p * 32, s + 32768 + p * 8192);
            if (NB == 2) glds16(b1 + kt * 64 + p * 32, s + 32768 + 16384 + p * 8192);
        }
    };
    stage(0, 0);
    for (int kt = 0; kt < nk; ++kt) {
        asm volatile("s_waitcnt vmcnt(0)" ::: "memory");
        __syncthreads();
        if (kt + 1 < nk) stage(kt + 1, (kt + 1) & 1);
        const unsigned char* s = lds + (kt & 1) * STAGE;
#pragma unroll
        for (int p = 0; p < 2; ++p) {
            bf16x8 af[4], bfr[NB][4];
#pragma unroll
            for (int m = 0; m < 4; ++m) af[m] = *(const bf16x8*)(s + p * 16384 + (wr * 64 + m * 16 + fr) * 64 + fq * 16);
#pragma unroll
            for (int b = 0; b < NB; ++b)
#pragma unroll
                for (int n = 0; n < 4; ++n) bfr[b][n] = *(const bf16x8*)(s + 32768 + b * 16384 + p * 8192 + (wc * 64 + n * 16 + fr) * 64 + fq * 16);
#pragma unroll
            for (int b = 0; b < NB; ++b)
#pragma unroll
                for (int m = 0; m < 4; ++m)
#pragma unroll
                    for (int n = 0; n < 4; ++n) acc[b][m][n] = __builtin_amdgcn_mfma_f32_16x16x32_bf16(bfr[b][n], af[m], acc[b][m][n], 0, 0, 0);
        }
    }
    __syncthreads();
}

__device__ const double k_rope_consts[10] = {1.0, 0.19392274474868576, 0.03760603093086393, 0.007292664737217109, 0.001414213562373095,
                                             0.0002742481756762073, 5.318295896944988e-05, 1.031338537721246e-05, 6.283185307179586, 0.15915494309189535};
DEVFI void transpose_item(const float* W, int ldw, int n_src0, int ncols, bf16_t* WT, int K, int dst_row0, int k0, float* scr, int lane) {
    const int c = lane & 31; const bool okc = c < ncols;
#pragma unroll 8
    for (int i = 0; i < 32; ++i) { const int kk = 2 * i + (lane >> 5); scr[kk * 33 + c] = okc ? W[(size_t)(k0 + kk) * ldw + n_src0 + c] : 0.f; }
    asm volatile("s_waitcnt lgkmcnt(0)" ::: "memory");
    const int ch = lane & 7;
#pragma unroll
    for (int j = 0; j < 4; ++j) {
        const int n = (lane >> 3) + 8 * j; const float* s = scr + (8 * ch) * 33 + n;
        uint4 o; o.x = pk2(s[0 * 33], s[1 * 33]); o.y = pk2(s[2 * 33], s[3 * 33]); o.z = pk2(s[4 * 33], s[5 * 33]); o.w = pk2(s[6 * 33], s[7 * 33]);
        if (n < ncols) *(uint4*)(WT + (size_t)(dst_row0 + n) * K + k0 + 8 * ch) = o;
    }
    asm volatile("s_waitcnt lgkmcnt(0)" ::: "memory");
}
struct TJob { const float* W; bf16_t* WT; int K, ldw, n_src0, ncols, dst_row0, nb; size_t sstride, dstride; };
DEVFI void run_tjob(const TJob& j, float* scr, int gw, int ngw, int lane) {
    const int nkb = j.K / 64, nnb = (j.ncols + 31) / 32, per = nkb * nnb, total = per * j.nb;
    for (int it = gw; it < total; it += ngw) {
        const int b = it / per, r = it % per, kb = r / nnb, nb = r % nnb;
        const int nc = (j.ncols - nb * 32) < 32 ? (j.ncols - nb * 32) : 32;
        transpose_item(j.W + (size_t)b * j.sstride, j.ldw, j.n_src0 + nb * 32, nc, j.WT + (size_t)b * j.dstride, j.K, j.dst_row0 + nb * 32, kb * 64, scr, lane);
    }
}

DEVFI void phase_prep(KP p, unsigned char* lds) {
    const int tid = opaque_tid(), lane = tid & 63, wid = tid >> 6;
    const int gw = blockIdx.x * 8 + wid, ngw = gridDim.x * 8;
    const int gt = blockIdx.x * 512 + tid, ngt = gridDim.x * 512;
    float* scr = (float*)(lds + wid * 8704);
    unsigned char* ws = p->ws;
    for (int l = 0; l < DEPTH; ++l) {
        const float* win = (const float*)p->in[4] + (size_t)l * 1024 * IN_COLS;
        bf16_t* wint = (bf16_t*)(ws + WS_WIN) + (size_t)l * ZN * 1024;
        TJob j;
        j.nb = 1; j.sstride = 0; j.dstride = 0;
        j.W = win; j.WT = wint; j.K = 1024; j.ldw = IN_COLS;
        j.n_src0 = 0; j.ncols = 1280; j.dst_row0 = 0; run_tjob(j, scr, gw, ngw, lane);
        j.n_src0 = SC_NG; j.ncols = 24; j.dst_row0 = ZC_NG; run_tjob(j, scr, gw, ngw, lane);
        j.n_src0 = SC_U; j.ncols = 256; j.dst_row0 = ZC_U; run_tjob(j, scr, gw, ngw, lane);
        j.n_src0 = SC_GA; j.ncols = 1024; j.dst_row0 = ZC_GA; run_tjob(j, scr, gw, ngw, lane);
        j.n_src0 = SC_GS; j.ncols = 1024; j.dst_row0 = ZC_GS; run_tjob(j, scr, gw, ngw, lane);
        { uint4* z = (uint4*)(wint + (size_t)IN_COLS * 1024); const int n16 = (ZN - IN_COLS) * 1024 * 2 / 16;
          const unsigned uz = __float_as_uint(opaque_zero());
          for (int i = gt; i < n16; i += ngt) z[i] = make_uint4(uz, uz, uz, uz); }
        j.K = 2048; j.ldw = 128; j.n_src0 = 0; j.ncols = 128; j.dst_row0 = 0;
        j.W = (const float*)p->in[8] + (size_t)l * 2048 * 128; j.WT = (bf16_t*)(ws + WS_CW1) + (size_t)(l * 2 + 0) * 128 * 2048; run_tjob(j, scr, gw, ngw, lane);
        j.W = (const float*)p->in[11] + (size_t)l * 2048 * 128; j.WT = (bf16_t*)(ws + WS_CW1) + (size_t)(l * 2 + 1) * 128 * 2048; run_tjob(j, scr, gw, ngw, lane);
        j.K = 256; j.ldw = 512; j.ncols = 512; j.W = (const float*)p->in[21] + (size_t)l * 256 * 512; j.WT = (bf16_t*)(ws + WS_GLU) + (size_t)l * 512 * 256; run_tjob(j, scr, gw, ngw, lane);
        j.K = 512; j.ldw = 1024; j.ncols = 1024; j.W = (const float*)p->in[22] + (size_t)l * 512 * 1024; j.WT = (bf16_t*)(ws + WS_PA) + (size_t)l * 1024 * 512; run_tjob(j, scr, gw, ngw, lane);
        j.K = 256; j.ldw = 1024; j.ncols = 1024; j.W = (const float*)p->in[23] + (size_t)l * 256 * 1024; j.WT = (bf16_t*)(ws + WS_PS) + (size_t)l * 1024 * 256; run_tjob(j, scr, gw, ngw, lane);
        j.K = 1024; j.ldw = 1024; j.ncols = 1024; j.W = (const float*)p->in[24] + (size_t)l * 1024 * 1024; j.WT = (bf16_t*)(ws + WS_WO) + (size_t)l * 1024 * 1024; run_tjob(j, scr, gw, ngw, lane);
        j.nb = 32;
        j.K = 1024; j.ldw = 512; j.ncols = 512; j.sstride = (size_t)1024 * 512; j.dstride = (size_t)512 * 1024;
        j.W = (const float*)p->in[29] + (size_t)l * 32 * 1024 * 512; j.WT = (bf16_t*)(ws + WS_EG) + (size_t)l * 32 * 512 * 1024; run_tjob(j, scr, gw, ngw, lane);
        j.W = (const float*)p->in[30] + (size_t)l * 32 * 1024 * 512; j.WT = (bf16_t*)(ws + WS_EU) + (size_t)l * 32 * 512 * 1024; run_tjob(j, scr, gw, ngw, lane);
        j.K = 512; j.ldw = 1024; j.ncols = 1024; j.sstride = (size_t)512 * 1024; j.dstride = (size_t)1024 * 512;
        j.W = (const float*)p->in[31] + (size_t)l * 32 * 512 * 1024; j.WT = (bf16_t*)(ws + WS_ED) + (size_t)l * 32 * 1024 * 512; run_tjob(j, scr, gw, ngw, lane);
    }
    {
        const int* pos = (const int*)p->in[1]; float* rope = (float*)(ws + WS_ROPE);
        for (int i = gt; i < NTOK * 8; i += ngt) {
            const int n = i >> 3, f = i & 7;
            const double ang = (double)pos[n] * k_rope_consts[f];
            const double r = ang - k_rope_consts[8] * __builtin_rint(ang * k_rope_consts[9]);
            const float rf = (float)r;
            rope[n * 16 + f] = cosf(rf); rope[n * 16 + 8 + f] = sinf(rf);
        }
    }
    {
        float* LB = (float*)(ws + WS_S5LB); float* BB = (float*)(ws + WS_S5BB);
        const float* are = (const float*)p->in[13]; const float* aim = (const float*)p->in[14]; const float* ldt = (const float*)p->in[15];
        const float* bre = (const float*)p->in[16]; const float* bim = (const float*)p->in[17];
        for (int i = gt; i < DEPTH * 16 * 64; i += ngt) {
            const int lg = i >> 6;
            const float lre = fminf(are[i], -1e-4f), lim = aim[i];
            const float dt = expf(ldt[lg]);
            const float a = lre * dt, bq = lim * dt;
            const float em = expm1f(a), cb = cosf(bq), sb = sinf(bq), sh = sinf(0.5f * bq);
            const float lbr = (em + 1.f) * cb, lbi = (em + 1.f) * sb, lm1 = em * cb - 2.f * sh * sh;
            const float den = lre * lre + lim * lim;
            const float fr_ = (lm1 * lre + lbi * lim) / den, fi_ = (lbi * lre - lm1 * lim) / den;
            LB[i * 2] = lbr; LB[i * 2 + 1] = lbi;
            for (int c = 0; c < 16; ++c) {
                const float br = bre[(size_t)i * 16 + c], bi = bim[(size_t)i * 16 + c];
                BB[((size_t)i * 16 + c) * 2] = fr_ * br - fi_ * bi;
                BB[((size_t)i * 16 + c) * 2 + 1] = fr_ * bi + fi_ * br;
            }
        }
    }
    {
        float* CB = (float*)(ws + WS_CB1);
        for (int o = gw; o < DEPTH * 2 * 128; o += ngw) {
            const int l = o >> 8, kv = (o >> 7) & 1, jn = o & 127;
            const float* pe = (const float*)p->in[kv ? 10 : 7] + (size_t)l * 2048;
            const float* w1 = (const float*)p->in[kv ? 11 : 8] + (size_t)l * 2048 * 128;
            float s = 0.f;
            for (int k = lane; k < 2048; k += 64) s += pe[k] * w1[(size_t)k * 128 + jn];
            s = wave_sum(s);
            if (lane == 0) CB[o] = s;
        }
    }
}

DEVFI int seg_start_lane(const int* cnt, int lane) {
    const int c = (lane < 32) ? cnt[lane] : 0;
    const int pad = (c + 255) & ~255;
    int incl = pad;
#pragma unroll
    for (int o = 1; o < 32; o <<= 1) { const int v = __shfl_up(incl, o); if ((lane & 31) >= o) incl += v; }
    return incl - pad;
}

DEVFI void stage_norm1(KP p, int l, bool final_only) {
    const int tid = opaque_tid(), lane = tid & 63, wid = tid >> 6;
    const int gw = blockIdx.x * 8 + wid, ngw = gridDim.x * 8;
    unsigned char* ws = p->ws;
    const float* xin = (const float*)p->in[0];
    float* xres = p->out;
    bf16_t* H = (bf16_t*)(ws + WS_H);
    const bf16_t* Y = (const bf16_t*)(ws + WS_Y);
    const int* eid = (const int*)(ws + WS_EID); const float* ew = (const float*)(ws + WS_EW); const int* epos = (const int*)(ws + WS_EPOS);
    int segs = 0;
    if (l > 0) segs = seg_start_lane((const int*)(ws + CTL_CNT) + (l - 1) * 32, lane);
    const float* gain = final_only ? nullptr : (const float*)p->in[2] + (size_t)l * 1024;
    for (int row = gw; row < NTOK; row += ngw) {
        f32x4 v[4];
        if (l == 0) {
#pragma unroll
            for (int j = 0; j < 4; ++j) v[j] = *(const f32x4*)(xin + (size_t)row * 1024 + lane * 4 + 256 * j);
        } else {
            const int e0 = eid[row * 2], e1 = eid[row * 2 + 1];
            const float w0 = ew[row * 2], w1 = ew[row * 2 + 1];
            const int s0 = __shfl(segs, e0) + epos[row * 2], s1 = __shfl(segs, e1) + epos[row * 2 + 1];
#pragma unroll
            for (int j = 0; j < 4; ++j) {
                v[j] = *(const f32x4*)(xres + (size_t)row * 1024 + lane * 4 + 256 * j);
                const uint2 ya = *(const uint2*)(Y + (size_t)s0 * 1024 + lane * 4 + 256 * j);
                const uint2 yb = *(const uint2*)(Y + (size_t)s1 * 1024 + lane * 4 + 256 * j);
                float a0 = __uint_as_float(ya.x << 16), a1 = __uint_as_float(ya.x & 0xffff0000u), a2 = __uint_as_float(ya.y << 16), a3 = __uint_as_float(ya.y & 0xffff0000u);
                float b0 = __uint_as_float(yb.x << 16), b1 = __uint_as_float(yb.x & 0xffff0000u), b2 = __uint_as_float(yb.y << 16), b3 = __uint_as_float(yb.y & 0xffff0000u);
                v[j][0] += w0 * a0 + w1 * b0; v[j][1] += w0 * a1 + w1 * b1; v[j][2] += w0 * a2 + w1 * b2; v[j][3] += w0 * a3 + w1 * b3;
            }
        }
#pragma unroll
        for (int j = 0; j < 4; ++j) *(f32x4*)(xres + (size_t)row * 1024 + lane * 4 + 256 * j) = v[j];
        if (final_only) continue;
        float ss = 0.f;
#pragma unroll
        for (int j = 0; j < 4; ++j) ss += v[j][0] * v[j][0] + v[j][1] * v[j][1] + v[j][2] * v[j][2] + v[j][3] * v[j][3];
        ss = wave_sum(ss);
        const float rstd = rsqrtf(ss * (1.f / 1024.f) + RMS_EPS);
#pragma unroll
        for (int j = 0; j < 4; ++j) {
            const f32x4 g = *(const f32x4*)(gain + lane * 4 + 256 * j);
            uint2 o; o.x = pk2(v[j][0] * rstd * g[0], v[j][1] * rstd * g[1]); o.y = pk2(v[j][2] * rstd * g[2], v[j][3] * rstd * g[3]);
            *(uint2*)(H + (size_t)row * 1024 + lane * 4 + 256 * j) = o;
        }
    }
}

DEVFI void stage_inproj(KP p, int l, unsigned char* lds) {
    const int tid = opaque_tid(), lane = tid & 63, wid = tid >> 6, wr = wid >> 1, wc = wid & 1, fr = lane & 15, fq = lane >> 4;
    unsigned char* ws = p->ws;
    const bf16_t* H = (const bf16_t*)(ws + WS_H);
    const bf16_t* W = (const bf16_t*)(ws + WS_WIN) + (size_t)l * ZN * 1024;
    bf16_t* Z = (bf16_t*)(ws + WS_Z);
    constexpr int NMT = NTOK / 256, NNT = ZN / 128;
    for (int u = blockIdx.x; u < NMT * NNT; u += gridDim.x) {
        const int mt = u % NMT, nt = u / NMT;
        const bf16_t* a0 = H + (size_t)(mt * 256 + (tid >> 2)) * 1024 + (tid & 3) * 8;
        const bf16_t* a1 = a0 + (size_t)128 * 1024;
        const bf16_t* b0 = W + (size_t)(nt * 128 + (tid >> 2)) * 1024 + (tid & 3) * 8;
        f32x4 acc[1][4][4];
        gemm_tile<1>(lds, a0, a1, 64, b0, nullptr, 16, acc);
#pragma unroll
        for (int m = 0; m < 4; ++m)
#pragma unroll
            for (int n = 0; n < 4; ++n) {
                const int row = mt * 256 + wr * 64 + m * 16 + fr, col = nt * 128 + wc * 64 + n * 16 + fq * 4;
                uint2 o; o.x = pk2(acc[0][m][n][0], acc[0][m][n][1]); o.y = pk2(acc[0][m][n][2], acc[0][m][n][3]);
                *(uint2*)(Z + (size_t)row * ZN + col) = o;
            }
    }
}

DEVFI void stage_posta(KP p, int l, unsigned char* lds) {
    const int tid = opaque_tid(), lane = tid & 63, wid = tid >> 6, wr = wid >> 1, wc = wid & 1, fr = lane & 15, fq = lane >> 4;
    const int gw = blockIdx.x * 8 + wid, ngw = gridDim.x * 8;
    const int gt = blockIdx.x * 512 + tid, ngt = gridDim.x * 512;
    unsigned char* ws = p->ws;
    bf16_t* Z = (bf16_t*)(ws + WS_Z);
    {
        const float* LB = (const float*)(ws + WS_S5LB) + (size_t)l * 16 * 64 * 2;
        const float* BB = (const float*)(ws + WS_S5BB) + (size_t)l * 16 * 64 * 16 * 2;
        float* X = (float*)(ws + WS_S5X);
        for (int item = blockIdx.x; item < BATCH * 16; item += gridDim.x) {
            if (wid != 0) continue;
            const int b = item >> 4, g = item & 15;
            const float lbr = LB[(g * 64 + lane) * 2], lbi = LB[(g * 64 + lane) * 2 + 1];
            float br[16], bi[16];
#pragma unroll
            for (int c = 0; c < 16; ++c) { br[c] = BB[((size_t)(g * 64 + lane) * 16 + c) * 2]; bi[c] = BB[((size_t)(g * 64 + lane) * 16 + c) * 2 + 1]; }
            float xr = 0.f, xi = 0.f;
            for (int t = 0; t < SEQ; ++t) {
                const bf16_t* up = Z + (size_t)(b * SEQ + t) * ZN + ZC_U + g * 16;
                const uint4 u0 = *(const uint4*)up, u1 = *(const uint4*)(up + 8);
                float u[16]; unpack8(u0, u); unpack8(u1, u + 8);
                float ar = 0.f, ai = 0.f;
#pragma unroll
                for (int c = 0; c < 16; ++c) { ar += br[c] * u[c]; ai += bi[c] * u[c]; }
                const float nr = lbr * xr - lbi * xi + ar, ni = lbr * xi + lbi * xr + ai;
                xr = nr; xi = ni;
                *(float2*)(X + ((size_t)(b * SEQ + t) * 16 + g) * 128 + lane * 2) = make_float2(xr, xi);
            }
        }
    }
    {
        const float* rope = (const float*)(ws + WS_ROPE);
        const float* qg = (const float*)p->in[5] + l * 64; const float* kg = (const float*)p->in[6] + l * 64;
        for (int i = gt; i < NTOK * 12; i += ngt) {
            const int n = i / 12, hs = i % 12;
            const int col = hs < 8 ? ZC_Q + hs * 64 : (hs < 10 ? ZC_KS + (hs - 8) * 64 : ZC_KW + (hs - 10) * 64);
            const float* gn = hs < 8 ? qg : kg;
            bf16_t* zp = Z + (size_t)n * ZN + col;
            float v[64];
#pragma unroll
            for (int j = 0; j < 8; ++j) unpack8(*(const uint4*)(zp + j * 8), v + j * 8);
            float ss = 0.f;
#pragma unroll
            for (int j = 0; j < 64; ++j) ss += v[j] * v[j];
            const float rstd = rsqrtf(ss * (1.f / 64.f) + RMS_EPS);
#pragma unroll
            for (int j = 0; j < 64; ++j) v[j] = v[j] * rstd * gn[j];
#pragma unroll
            for (int f = 0; f < 8; ++f) {
                const float c = rope[n * 16 + f], s = rope[n * 16 + 8 + f];
                const float x1 = v[f], x2 = v[8 + f];
                v[f] = x1 * c - x2 * s; v[8 + f] = x2 * c + x1 * s;
            }
#pragma unroll
            for (int j = 0; j < 8; ++j) {
                uint4 o; o.x = pk2(v[j * 8], v[j * 8 + 1]); o.y = pk2(v[j * 8 + 2], v[j * 8 + 3]); o.z = pk2(v[j * 8 + 4], v[j * 8 + 5]); o.w = pk2(v[j * 8 + 6], v[j * 8 + 7]);
                *(uint4*)(zp + j * 8) = o;
            }
        }
    }
    {
        const bf16_t* W1 = (const bf16_t*)(ws + WS_CW1) + (size_t)l * 2 * 128 * 2048;
        const float* CB = (const float*)(ws + WS_CB1) + l * 256;
        bf16_t* HID = (bf16_t*)(ws + WS_HID);
        constexpr int MR = BATCH * 2 * NCMP;
        for (int uu = (int)((blockIdx.x + gridDim.x / 2) % gridDim.x); uu < 16; uu += gridDim.x) {
            const int u = uu;
            const int kv = u >> 3, mt = u & 7;
            auto rowptr = [&](int r) -> const bf16_t* {
                if (r >= MR) r = MR - 1;
                const int bh = r / NCMP, c = r % NCMP, b = bh >> 1, hk = bh & 1;
                return Z + (size_t)(b * SEQ + 16 * c) * ZN + (kv ? ZC_VC : ZC_KC) + hk * 64;
            };
            const bf16_t* a0 = rowptr(mt * 256 + (tid >> 2)) + (tid & 3) * 8;
            const bf16_t* a1 = rowptr(mt * 256 + 128 + (tid >> 2)) + (tid & 3) * 8;
            const bf16_t* b0 = W1 + (size_t)kv * 128 * 2048 + (size_t)(tid >> 2) * 2048 + (tid & 3) * 8;
            f32x4 acc[1][4][4];
            gemm_tile<1>(lds, a0, a1, ZN, b0, nullptr, 32, acc);
#pragma unroll
            for (int m = 0; m < 4; ++m)
#pragma unroll
                for (int n = 0; n < 4; ++n) {
                    const int row = mt * 256 + wr * 64 + m * 16 + fr, col = wc * 64 + n * 16 + fq * 4;
                    float o[4];
#pragma unroll
                    for (int r = 0; r < 4; ++r) o[r] = gelu_tanh(acc[0][m][n][r] + CB[kv * 128 + col + r]);
                    uint2 w; w.x = pk2(o[0], o[1]); w.y = pk2(o[2], o[3]);
                    if (row < MR) *(uint2*)(HID + ((size_t)kv * 2048 + row) * 128 + col) = w;
                }
        }
    }
    (void)gw; (void)ngw;
}

DEVFI void stage_postb(KP p, int l) {
    const int tid = opaque_tid();
    const int gt = blockIdx.x * 512 + tid, ngt = gridDim.x * 512;
    unsigned char* ws = p->ws;
    {
        const bf16_t* HID = (const bf16_t*)(ws + WS_HID);
        const float* rope = (const float*)(ws + WS_ROPE);
        const float* kg = (const float*)p->in[6] + l * 64;
        constexpr int MR = BATCH * 2 * NCMP;
        for (int i = gt; i < 2 * MR; i += ngt) {
            const int kv = i / MR, r = i % MR;
            const int bh = r / NCMP, c = r % NCMP, b = bh >> 1;
            const float* w2 = (const float*)p->in[kv ? 12 : 9] + (size_t)l * 128 * 64;
            const bf16_t* hp = HID + ((size_t)kv * 2048 + r) * 128;
            float o[64];
#pragma unroll
            for (int d = 0; d < 64; ++d) o[d] = 0.f;
            for (int k8 = 0; k8 < 16; ++k8) {
                float hv[8]; unpack8(*(const uint4*)(hp + k8 * 8), hv);
#pragma unroll
                for (int kk = 0; kk < 8; ++kk) {
                    const float* wrow = w2 + (size_t)(k8 * 8 + kk) * 64;
#pragma unroll
                    for (int d = 0; d < 64; ++d) o[d] += hv[kk] * wrow[d];
                }
            }
            float* dst = (float*)(ws + (kv ? WS_VC : WS_KC)) + ((size_t)bh * 128 + c) * 64;
            if (kv == 0) {
                float ss = 0.f;
#pragma unroll
                for (int d = 0; d < 64; ++d) ss += o[d] * o[d];
                const float rstd = rsqrtf(ss * (1.f / 64.f) + RMS_EPS);
#pragma unroll
                for (int d = 0; d < 64; ++d) o[d] = o[d] * rstd * kg[d];
                const int n = b * SEQ + 16 * c + 31;
#pragma unroll
                for (int f = 0; f < 8; ++f) {
                    const float cs = rope[n * 16 + f], sn = rope[n * 16 + 8 + f];
                    const float x1 = o[f], x2 = o[8 + f];
                    o[f] = x1 * cs - x2 * sn; o[8 + f] = x2 * cs + x1 * sn;
                }
            }
#pragma unroll
            for (int d = 0; d < 64; d += 4) *(f32x4*)(dst + d) = (f32x4){o[d], o[d + 1], o[d + 2], o[d + 3]};
        }
    }
    {
        const int tid = opaque_tid();
        const int gt = blockIdx.x * 512 + tid, ngt = gridDim.x * 512;
        const float* X = (const float*)(ws + WS_S5X);
        const float* cre = (const float*)p->in[18] + (size_t)l * 16 * 16 * 64; const float* cim = (const float*)p->in[19] + (size_t)l * 16 * 16 * 64;
        const float* dsk = (const float*)p->in[20] + l * 256;
        const bf16_t* Z = (const bf16_t*)(ws + WS_Z);
        bf16_t* YB = (bf16_t*)(ws + WS_YB);
        for (int i = gt; i < NTOK * 256; i += ngt) {
            const int n = i >> 8, gc = i & 255, g = gc >> 4;
            const float* xp = X + ((size_t)n * 16 + g) * 128;
            const float* cr = cre + (size_t)gc * 64; const float* ci = cim + (size_t)gc * 64;
            float y = 0.f;
            for (int pq = 0; pq < 64; pq += 2) {
                const f32x4 xv = *(const f32x4*)(xp + pq * 2);
                y += xv[0] * cr[pq] - xv[1] * ci[pq] + xv[2] * cr[pq + 1] - xv[3] * ci[pq + 1];
            }
            y += dsk[gc] * bf2f(Z[(size_t)n * ZN + ZC_U + gc]);
            YB[(size_t)n * 256 + gc] = (bf16_t)f2bf(gelu_tanh(y));
        }
    }
}

DEVFI void stage_cmpatt(KP p, int l, unsigned char* lds) {
    const int tid = opaque_tid(), lane = tid & 63, wid = tid >> 6, wr = wid >> 1, wc = wid & 1, fr = lane & 15, fq = lane >> 4;
    const int gt = blockIdx.x * 512 + tid, ngt = gridDim.x * 512;
    unsigned char* ws = p->ws;
    const bf16_t* Z = (const bf16_t*)(ws + WS_Z);
    {
        const float* KC = (const float*)(ws + WS_KC); const float* VC = (const float*)(ws + WS_VC);
        float* OC = (float*)(ws + WS_OCMP);
        for (int idx = gt; idx < BATCH * 2 * SEQ; idx += ngt) {
            const int bh = idx >> 11, t = idx & 2047, b = bh >> 1, hk = bh & 1;
            const int ncv = t >= 31 ? ((t - 31) >> 4) + 1 : 0;
            float* sc = (float*)(ws + WS_SC) + (size_t)idx * 128;
            float* pcs = (float*)(ws + WS_PCS) + (size_t)idx * 128;
            { const float fz = opaque_zero(); for (int c = 0; c < ncv; ++c) pcs[c] = fz; }
            const float* kcb = KC + (size_t)bh * 128 * 64; const float* vcb = VC + (size_t)bh * 128 * 64;
            for (int g = 0; g < 4; ++g) {
                const int h = hk * 4 + g;
                const bf16_t* qp = Z + (size_t)(b * SEQ + t) * ZN + ZC_Q + h * 64;
                float q[64];
#pragma unroll
                for (int j = 0; j < 8; ++j) unpack8(*(const uint4*)(qp + j * 8), q + j * 8);
                float mx = -1e30f;
                for (int c = 0; c < ncv; ++c) {
                    const float* kr = kcb + c * 64; float s = 0.f;
#pragma unroll
                    for (int d = 0; d < 64; ++d) s += q[d] * kr[d];
                    s *= 0.125f; sc[c] = s; mx = fmaxf(mx, s);
                }
                float sum = 0.f;
                for (int c = 0; c < ncv; ++c) sum += __expf(sc[c] - mx);
                const float inv = ncv > 0 ? 1.f / sum : 0.f;
                float o[64];
#pragma unroll
                for (int d = 0; d < 64; ++d) o[d] = 0.f;
                for (int c = 0; c < ncv; ++c) {
                    const float pr = __expf(sc[c] - mx) * inv; pcs[c] += pr;
                    const float* vr = vcb + c * 64;
#pragma unroll
                    for (int d = 0; d < 64; ++d) o[d] += pr * vr[d];
                }
                float* op = OC + (size_t)(b * SEQ + t) * 512 + h * 64;
#pragma unroll
                for (int d = 0; d < 64; d += 4) *(f32x4*)(op + d) = (f32x4){o[d], o[d + 1], o[d + 2], o[d + 3]};
            }
            float* imp = (float*)(ws + WS_IMP) + (size_t)idx * 32;
            const int cur = t >> 6;
            for (int j = 0; j < 32; ++j) {
                float v = 0.f;
                const int c0 = 4 * j - 1 < 0 ? 0 : 4 * j - 1, c1 = 4 * j + 3 > 126 ? 126 : 4 * j + 3;
                for (int c = c0; c <= c1; ++c) if (c < ncv) v += pcs[c];
                const bool forced = (j == 0) | (j == cur) | (j == cur - 1);
                imp[j] = forced ? __builtin_inff() : (j > cur ? -__builtin_inff() : v);
            }
            unsigned mask = 0u;
            for (int j = 0; j < 32; ++j) {
                const float vj = imp[j]; int rank = 0;
                for (int m = 0; m < 32; ++m) { const float vm = imp[m]; rank += (vm > vj || (vm == vj && m < j)) ? 1 : 0; }
                if (rank < 16) mask |= 1u << j;
            }
            ((unsigned*)(ws + WS_SEL))[idx] = mask;
        }
    }
    {
        const bf16_t* YB = (const bf16_t*)(ws + WS_YB);
        const bf16_t* G = (const bf16_t*)(ws + WS_GLU) + (size_t)l * 512 * 256;
        bf16_t* OB = (bf16_t*)(ws + WS_OB);
        for (int u = blockIdx.x; u < 64 * 4; u += gridDim.x) {
            const int mt = u >> 2, nt = u & 3;
            const bf16_t* a0 = YB + (size_t)(mt * 256 + (tid >> 2)) * 256 + (tid & 3) * 8;
            const bf16_t* a1 = a0 + (size_t)128 * 256;
            const int brow = tid >> 2, sub = brow >> 4;
            const bf16_t* b0 = G + (size_t)((sub & 1) * 256 + nt * 64 + (sub >> 1) * 16 + (brow & 15)) * 256 + (tid & 3) * 8;
            f32x4 acc[1][4][4];
            gemm_tile<1>(lds, a0, a1, 64, b0, nullptr, 4, acc);
#pragma unroll
            for (int m = 0; m < 4; ++m)
#pragma unroll
                for (int n = 0; n < 4; n += 2) {
                    const int row = mt * 256 + wr * 64 + m * 16 + fr, col = nt * 64 + (wc * 2 + (n >> 1)) * 16 + fq * 4;
                    float o[4];
#pragma unroll
                    for (int r = 0; r < 4; ++r) o[r] = acc[0][m][n][r] * sigmoidf_(acc[0][m][n + 1][r]);
                    uint2 w; w.x = pk2(o[0], o[1]); w.y = pk2(o[2], o[3]);
                    *(uint2*)(OB + (size_t)row * 256 + col) = w;
                }
        }
    }
}

DEVFI void stage_att(KP p, int l) {
    const int tid = opaque_tid();
    const int gt = blockIdx.x * 512 + tid, ngt = gridDim.x * 512;
    unsigned char* ws = p->ws;
    const bf16_t* Z = (const bf16_t*)(ws + WS_Z);
    const unsigned* SEL = (const unsigned*)(ws + WS_SEL);
    float* OC = (float*)(ws + WS_OCMP);
    bf16_t* OA = (bf16_t*)(ws + WS_OA);
    for (int idx = gt; idx < BATCH * NH * SEQ; idx += ngt) {
        const int bh = idx >> 11, t = idx & 2047, b = bh >> 3, h = bh & 7, hk = h >> 2;
        const unsigned mask = SEL[(b * 2 + hk) * SEQ + t];
        const bf16_t* zrow = Z + (size_t)(b * SEQ + t) * ZN;
        float q[64];
#pragma unroll
        for (int j = 0; j < 8; ++j) unpack8(*(const uint4*)(zrow + ZC_Q + h * 64 + j * 8), q + j * 8);
        const float g0 = sigmoidf_(bf2f(zrow[ZC_NG + h * 3])), g1 = sigmoidf_(bf2f(zrow[ZC_NG + h * 3 + 1])), g2 = sigmoidf_(bf2f(zrow[ZC_NG + h * 3 + 2]));
        float* ocp = OC + (size_t)(b * SEQ + t) * 512 + h * 64;
        const int cur = t >> 6, t0 = t & ~63;
        float o[64];
        {
            float mx = -1e30f, ls = 0.f;
#pragma unroll
            for (int d = 0; d < 64; ++d) o[d] = 0.f;
            for (int j = 0; j <= cur; ++j) {
                const bool sel = (mask >> j) & 1u;
                if (!__any(sel)) continue;
                for (int kk = 0; kk < 64; ++kk) {
                    const int kp = j * 64 + kk;
                    if (sel && kp <= t) {
                        const bf16_t* kr = Z + (size_t)(b * SEQ + kp) * ZN + ZC_KS + hk * 64;
                        float s = 0.f;
#pragma unroll
                        for (int j8 = 0; j8 < 8; ++j8) { float kf[8]; unpack8(*(const uint4*)(kr + j8 * 8), kf);
#pragma unroll
                            for (int e = 0; e < 8; ++e) s += q[j8 * 8 + e] * kf[e]; }
                        s *= 0.125f;
                        if (s > mx) { const float a = __expf(mx - s); ls *= a;
#pragma unroll
                            for (int d = 0; d < 64; ++d) o[d] *= a;
                            mx = s; }
                        const float pr = __expf(s - mx); ls += pr;
                        const bf16_t* vr = Z + (size_t)(b * SEQ + kp) * ZN + ZC_VS + hk * 64;
#pragma unroll
                        for (int j8 = 0; j8 < 8; ++j8) { float vf[8]; unpack8(*(const uint4*)(vr + j8 * 8), vf);
#pragma unroll
                            for (int e = 0; e < 8; ++e) o[j8 * 8 + e] += pr * vf[e]; }
                    }
                }
            }
            const float sc1 = g1 / ls;
#pragma unroll
            for (int d = 0; d < 64; d += 4) {
                f32x4 c = *(const f32x4*)(ocp + d);
                c[0] = g0 * c[0] + sc1 * o[d]; c[1] = g0 * c[1] + sc1 * o[d + 1]; c[2] = g0 * c[2] + sc1 * o[d + 2]; c[3] = g0 * c[3] + sc1 * o[d + 3];
                *(f32x4*)(ocp + d) = c;
            }
        }
        {
            float mx = -1e30f, ls = 0.f;
#pragma unroll
            for (int d = 0; d < 64; ++d) o[d] = 0.f;
            const int k0 = t0 - 511 < 0 ? 0 : t0 - 511;
            for (int kp = k0; kp <= t0 + 63; ++kp) {
                if (kp <= t && kp > t - 512) {
                    const bf16_t* kr = Z + (size_t)(b * SEQ + kp) * ZN + ZC_KW + hk * 64;
                    float s = 0.f;
#pragma unroll
                    for (int j8 = 0; j8 < 8; ++j8) { float kf[8]; unpack8(*(const uint4*)(kr + j8 * 8), kf);
#pragma unroll
                        for (int e = 0; e < 8; ++e) s += q[j8 * 8 + e] * kf[e]; }
                    s *= 0.125f;
                    if (s > mx) { const float a = __expf(mx - s); ls *= a;
#pragma unroll
                        for (int d = 0; d < 64; ++d) o[d] *= a;
                        mx = s; }
                    const float pr = __expf(s - mx); ls += pr;
                    const bf16_t* vr = Z + (size_t)(b * SEQ + kp) * ZN + ZC_VW + hk * 64;
#pragma unroll
                    for (int j8 = 0; j8 < 8; ++j8) { float vf[8]; unpack8(*(const uint4*)(vr + j8 * 8), vf);
#pragma unroll
                        for (int e = 0; e < 8; ++e) o[j8 * 8 + e] += pr * vf[e]; }
                }
            }
            const float sc2 = g2 / ls;
            bf16_t* oap = OA + (size_t)(b * SEQ + t) * 512 + h * 64;
#pragma unroll
            for (int d = 0; d < 64; d += 8) {
                const f32x4 c0 = *(const f32x4*)(ocp + d), c1 = *(const f32x4*)(ocp + d + 4);
                uint4 w;
                w.x = pk2(c0[0] + sc2 * o[d], c0[1] + sc2 * o[d + 1]); w.y = pk2(c0[2] + sc2 * o[d + 2], c0[3] + sc2 * o[d + 3]);
                w.z = pk2(c1[0] + sc2 * o[d + 4], c1[1] + sc2 * o[d + 5]); w.w = pk2(c1[2] + sc2 * o[d + 6], c1[3] + sc2 * o[d + 7]);
                *(uint4*)(oap + d) = w;
            }
        }
    }
    (void)l;
}

DEVFI void stage_merge(KP p, int l, unsigned char* lds) {
    const int tid = opaque_tid(), lane = tid & 63, wid = tid >> 6, wr = wid >> 1, wc = wid & 1, fr = lane & 15, fq = lane >> 4;
    unsigned char* ws = p->ws;
    const bf16_t* OA = (const bf16_t*)(ws + WS_OA); const bf16_t* OB = (const bf16_t*)(ws + WS_OB);
    const bf16_t* PA = (const bf16_t*)(ws + WS_PA) + (size_t)l * 1024 * 512; const bf16_t* PS = (const bf16_t*)(ws + WS_PS) + (size_t)l * 1024 * 256;
    const bf16_t* Z = (const bf16_t*)(ws + WS_Z);
    bf16_t* MRG = (bf16_t*)(ws + WS_MRG);
    for (int u = blockIdx.x; u < 64 * 8; u += gridDim.x) {
        const int mt = u & 63, nt = u >> 6;
        f32x4 acc1[1][4][4], acc2[1][4][4];
        {
            const bf16_t* a0 = OA + (size_t)(mt * 256 + (tid >> 2)) * 512 + (tid & 3) * 8;
            const bf16_t* b0 = PA + (size_t)(nt * 128 + (tid >> 2)) * 512 + (tid & 3) * 8;
            gemm_tile<1>(lds, a0, a0 + (size_t)128 * 512, 64, b0, nullptr, 8, acc1);
        }
        {
            const bf16_t* a0 = OB + (size_t)(mt * 256 + (tid >> 2)) * 256 + (tid & 3) * 8;
            const bf16_t* b0 = PS + (size_t)(nt * 128 + (tid >> 2)) * 256 + (tid & 3) * 8;
            gemm_tile<1>(lds, a0, a0 + (size_t)128 * 256, 64, b0, nullptr, 4, acc2);
        }
#pragma unroll
        for (int m = 0; m < 4; ++m)
#pragma unroll
            for (int n = 0; n < 4; ++n) {
                const int row = mt * 256 + wr * 64 + m * 16 + fr, col = nt * 128 + wc * 64 + n * 16 + fq * 4;
                const uint2 ga = *(const uint2*)(Z + (size_t)row * ZN + ZC_GA + col), gs = *(const uint2*)(Z + (size_t)row * ZN + ZC_GS + col);
                const float a[4] = {__uint_as_float(ga.x << 16), __uint_as_float(ga.x & 0xffff0000u), __uint_as_float(ga.y << 16), __uint_as_float(ga.y & 0xffff0000u)};
                const float s[4] = {__uint_as_float(gs.x << 16), __uint_as_float(gs.x & 0xffff0000u), __uint_as_float(gs.y << 16), __uint_as_float(gs.y & 0xffff0000u)};
                float o[4];
#pragma unroll
                for (int r = 0; r < 4; ++r) o[r] = sigmoidf_(a[r]) * acc1[0][m][n][r] + sigmoidf_(s[r]) * acc2[0][m][n][r];
                uint2 w; w.x = pk2(o[0], o[1]); w.y = pk2(o[2], o[3]);
                *(uint2*)(MRG + (size_t)row * 1024 + col) = w;
            }
    }
}

DEVFI void stage_out(KP p, int l, unsigned char* lds) {
    const int tid = opaque_tid(), lane = tid & 63, wid = tid >> 6, wr = wid >> 1, wc = wid & 1, fr = lane & 15, fq = lane >> 4;
    unsigned char* ws = p->ws;
    const bf16_t* MRG = (const bf16_t*)(ws + WS_MRG);
    const bf16_t* WO = (const bf16_t*)(ws + WS_WO) + (size_t)l * 1024 * 1024;
    float* xres = p->out;
    for (int u = blockIdx.x; u < 64 * 8; u += gridDim.x) {
        const int mt = u & 63, nt = u >> 6;
        const bf16_t* a0 = MRG + (size_t)(mt * 256 + (tid >> 2)) * 1024 + (tid & 3) * 8;
        const bf16_t* b0 = WO + (size_t)(nt * 128 + (tid >> 2)) * 1024 + (tid & 3) * 8;
        f32x4 acc[1][4][4];
        gemm_tile<1>(lds, a0, a0 + (size_t)128 * 1024, 64, b0, nullptr, 16, acc);
#pragma unroll
        for (int m = 0; m < 4; ++m)
#pragma unroll
            for (int n = 0; n < 4; ++n) {
                const int row = mt * 256 + wr * 64 + m * 16 + fr, col = nt * 128 + wc * 64 + n * 16 + fq * 4;
                float* xp = xres + (size_t)row * 1024 + col;
                *(f32x4*)xp = *(const f32x4*)xp + acc[0][m][n];
            }
    }
}

DEVFI void stage_route(KP p, int l) {
    const int tid = opaque_tid(), lane = tid & 63, wid = tid >> 6;
    const int gw = blockIdx.x * 8 + wid, ngw = gridDim.x * 8;
    unsigned char* ws = p->ws;
    const float* xres = p->out;
    bf16_t* H = (bf16_t*)(ws + WS_H);
    const float* gain = (const float*)p->in[3] + (size_t)l * 1024;
    const float* wrg = (const float*)p->in[25] + (size_t)l * 1024 * 4; const float* brg = (const float*)p->in[26] + l * 4;
    const float* wre = (const float*)p->in[27] + (size_t)l * 1024 * 32; const float* bre = (const float*)p->in[28] + l * 32;
    int* cnt = (int*)(ws + CTL_CNT) + l * 32;
    int* eid = (int*)(ws + WS_EID); float* ew = (float*)(ws + WS_EW); int* epos = (int*)(ws + WS_EPOS); int* list = (int*)(ws + WS_LIST);
    for (int row = gw; row < NTOK; row += ngw) {
        f32x4 v[4]; float ss = 0.f;
#pragma unroll
        for (int j = 0; j < 4; ++j) { v[j] = *(const f32x4*)(xres + (size_t)row * 1024 + lane * 4 + 256 * j); ss += v[j][0] * v[j][0] + v[j][1] * v[j][1] + v[j][2] * v[j][2] + v[j][3] * v[j][3]; }
        ss = wave_sum(ss);
        const float rstd = rsqrtf(ss * (1.f / 1024.f) + RMS_EPS);
        float lg[36];
#pragma unroll
        for (int o = 0; o < 36; ++o) lg[o] = 0.f;
#pragma unroll
        for (int j = 0; j < 4; ++j) {
            const f32x4 g = *(const f32x4*)(gain + lane * 4 + 256 * j);
            float hn[4];
#pragma unroll
            for (int r = 0; r < 4; ++r) hn[r] = v[j][r] * rstd * g[r];
            uint2 o; o.x = pk2(hn[0], hn[1]); o.y = pk2(hn[2], hn[3]);
            *(uint2*)(H + (size_t)row * 1024 + lane * 4 + 256 * j) = o;
#pragma unroll
            for (int r = 0; r < 4; ++r) {
                const int k = lane * 4 + 256 * j + r;
                const f32x4 wg = *(const f32x4*)(wrg + (size_t)k * 4);
#pragma unroll
                for (int o4 = 0; o4 < 4; ++o4) lg[o4] += hn[r] * wg[o4];
#pragma unroll
                for (int o8 = 0; o8 < 8; ++o8) {
                    const f32x4 we = *(const f32x4*)(wre + (size_t)k * 32 + o8 * 4);
                    lg[4 + o8 * 4] += hn[r] * we[0]; lg[5 + o8 * 4] += hn[r] * we[1]; lg[6 + o8 * 4] += hn[r] * we[2]; lg[7 + o8 * 4] += hn[r] * we[3];
                }
            }
        }
#pragma unroll
        for (int o = 0; o < 36; ++o) lg[o] = wave_sum(lg[o]);
        float gl[4];
#pragma unroll
        for (int i = 0; i < 4; ++i) gl[i] = lg[i] + brg[i];
        int gs = 0; float gm = gl[0];
#pragma unroll
        for (int i = 1; i < 4; ++i) if (gl[i] > gm) { gm = gl[i]; gs = i; }
        float gsum = 0.f;
#pragma unroll
        for (int i = 0; i < 4; ++i) gsum += __expf(gl[i] - gm);
        const float gwt = 1.f / gsum;
        float el[8];
#pragma unroll
        for (int i = 0; i < 8; ++i) {
            const float a = gs == 0 ? lg[4 + i] : (gs == 1 ? lg[12 + i] : (gs == 2 ? lg[20 + i] : lg[28 + i]));
            el[i] = a + bre[gs * 8 + i];
        }
        int i1 = 0; float m1 = el[0];
#pragma unroll
        for (int i = 1; i < 8; ++i) if (el[i] > m1) { m1 = el[i]; i1 = i; }
        int i2 = -1; float m2 = -__builtin_inff();
#pragma unroll
        for (int i = 0; i < 8; ++i) if (i != i1 && el[i] > m2) { m2 = el[i]; i2 = i; }
        const float e2 = __expf(m2 - m1);
        const float w1 = gwt / (1.f + e2), w2 = gwt * e2 / (1.f + e2);
        if (lane == 0) {
            const int ea = gs * 8 + i1, eb = gs * 8 + i2;
            const int pa = atomicAdd(cnt + ea, 1), pb = atomicAdd(cnt + eb, 1);
            eid[row * 2] = ea; eid[row * 2 + 1] = eb; ew[row * 2] = w1; ew[row * 2 + 1] = w2; epos[row * 2] = pa; epos[row * 2 + 1] = pb;
            list[ea * NTOK + pa] = row; list[eb * NTOK + pb] = row;
        }
    }
}

DEVFI bool find_tile(const int* cnt, int ti, int& e, int& mt, int& segstart, int& ecnt) {
    int acc_t = 0, acc_s = 0;
    for (int i = 0; i < 32; ++i) {
        const int c = cnt[i], nt = (c + 255) >> 8;
        if (ti < acc_t + nt) { e = i; mt = ti - acc_t; segstart = acc_s; ecnt = c; return true; }
        acc_t += nt; acc_s += nt << 8;
    }
    return false;
}

DEVFI void stage_gateup(KP p, int l, unsigned char* lds) {
    const int tid = opaque_tid(), lane = tid & 63, wid = tid >> 6, wr = wid >> 1, wc = wid & 1, fr = lane & 15, fq = lane >> 4;
    unsigned char* ws = p->ws;
    const bf16_t* H = (const bf16_t*)(ws + WS_H);
    const bf16_t* EG = (const bf16_t*)(ws + WS_EG) + (size_t)l * 32 * 512 * 1024; const bf16_t* EU = (const bf16_t*)(ws + WS_EU) + (size_t)l * 32 * 512 * 1024;
    const int* cnt = (const int*)(ws + CTL_CNT) + l * 32;
    const int* list = (const int*)(ws + WS_LIST);
    bf16_t* ACT = (bf16_t*)(ws + WS_ACT);
    for (int u = blockIdx.x;; u += gridDim.x) {
        const int ti = u >> 3, nt = u & 7;
        int e, mt, seg, ec;
        if (!find_tile(cnt, ti, e, mt, seg, ec)) break;
        int r0 = mt * 256 + (tid >> 2), r1 = r0 + 128;
        if (r0 >= ec) r0 = 0;
        if (r1 >= ec) r1 = 0;
        const int tk0 = list[e * NTOK + r0], tk1 = list[e * NTOK + r1];
        const bf16_t* a0 = H + (size_t)tk0 * 1024 + (tid & 3) * 8;
        const bf16_t* a1 = H + (size_t)tk1 * 1024 + (tid & 3) * 8;
        const int brow = tid >> 2, sub = brow >> 4;
        const bf16_t* b0 = ((sub & 1) ? EU : EG) + ((size_t)e * 512 + nt * 64 + (sub >> 1) * 16 + (brow & 15)) * 1024 + (tid & 3) * 8;
        f32x4 acc[1][4][4];
        gemm_tile<1>(lds, a0, a1, 64, b0, nullptr, 16, acc);
#pragma unroll
        for (int m = 0; m < 4; ++m)
#pragma unroll
            for (int n = 0; n < 4; n += 2) {
                const int slot = seg + mt * 256 + wr * 64 + m * 16 + fr, col = nt * 64 + (wc * 2 + (n >> 1)) * 16 + fq * 4;
                float o[4];
#pragma unroll
                for (int r = 0; r < 4; ++r) { const float g = acc[0][m][n][r]; o[r] = g * sigmoidf_(g) * acc[0][m][n + 1][r]; }
                uint2 w; w.x = pk2(o[0], o[1]); w.y = pk2(o[2], o[3]);
                *(uint2*)(ACT + (size_t)slot * 512 + col) = w;
            }
    }
}

DEVFI void stage_down(KP p, int l, unsigned char* lds) {
    const int tid = opaque_tid(), lane = tid & 63, wid = tid >> 6, wr = wid >> 1, wc = wid & 1, fr = lane & 15, fq = lane >> 4;
    unsigned char* ws = p->ws;
    const bf16_t* ACT = (const bf16_t*)(ws + WS_ACT);
    const bf16_t* ED = (const bf16_t*)(ws + WS_ED) + (size_t)l * 32 * 1024 * 512;
    const int* cnt = (const int*)(ws + CTL_CNT) + l * 32;
    bf16_t* Y = (bf16_t*)(ws + WS_Y);
    for (int u = blockIdx.x;; u += gridDim.x) {
        const int ti = u >> 3, nt = u & 7;
        int e, mt, seg, ec;
        if (!find_tile(cnt, ti, e, mt, seg, ec)) break;
        const bf16_t* a0 = ACT + (size_t)(seg + mt * 256 + (tid >> 2)) * 512 + (tid & 3) * 8;
        const bf16_t* b0 = ED + ((size_t)e * 1024 + nt * 128 + (tid >> 2)) * 512 + (tid & 3) * 8;
        f32x4 acc[1][4][4];
        gemm_tile<1>(lds, a0, a0 + (size_t)128 * 512, 64, b0, nullptr, 8, acc);
#pragma unroll
        for (int m = 0; m < 4; ++m)
#pragma unroll
            for (int n = 0; n < 4; ++n) {
                const int slot = seg + mt * 256 + wr * 64 + m * 16 + fr, col = nt * 128 + wc * 64 + n * 16 + fq * 4;
                uint2 w; w.x = pk2(acc[0][m][n][0], acc[0][m][n][1]); w.y = pk2(acc[0][m][n][2], acc[0][m][n][3]);
                *(uint2*)(Y + (size_t)slot * 1024 + col) = w;
            }
    }
}

__global__ void __launch_bounds__(512) mega(Params p0) {
    extern __shared__ __attribute__((aligned(16))) unsigned char lds[];
    volatile LAS unsigned* ctl = (volatile LAS unsigned*)(LAS unsigned char*)(lds + LDS_CTL);
    if (threadIdx.x < 64) ctl[threadIdx.x] = 0u;
    __syncthreads();
    XcdBarrier bar; bar.bar = (unsigned*)p0.ws; bar.x = 0; bar.st = ctl;
    const bool multi = (p0.ph_hi - p0.ph_lo) > 1;
    if (multi) bar = xcd_barrier_post((unsigned*)p0.ws, ctl);
    for (int ph = p0.ph_lo; ph < p0.ph_hi; ++ph) {
        KP p = (KP)__builtin_amdgcn_kernarg_segment_ptr();
        asm volatile("" : "+s"(p));
#ifndef ONLY
#define ONLY -1
#endif
#ifndef SKIP
#define SKIP -1
#endif
#define RUN(k) ((ONLY < 0 || ONLY == (k)) && SKIP != (k))
        if (ph == 0) { if (RUN(100)) phase_prep(p, lds); }
        else if (ph == NPHASE - 1) { if (RUN(0)) stage_norm1(p, DEPTH, true); }
        else {
            const int l = (ph - 1) / NST, s = (ph - 1) % NST;
            switch (s) {
                case 0: if (RUN(0)) stage_norm1(p, l, false); break;
                case 1: if (RUN(1)) stage_inproj(p, l, lds); break;
                case 2: if (RUN(2)) stage_posta(p, l, lds); break;
                case 3: if (RUN(3)) stage_postb(p, l); break;
                case 4: if (RUN(4)) stage_cmpatt(p, l, lds); break;
                case 5: if (RUN(5)) stage_att(p, l); break;
                case 6: if (RUN(6)) stage_merge(p, l, lds); break;
                case 7: if (RUN(7)) stage_out(p, l, lds); break;
                case 8: if (RUN(8)) stage_route(p, l); break;
                case 9: if (RUN(9)) stage_gateup(p, l, lds); break;
                default: if (RUN(10)) stage_down(p, l, lds); break;
            }
        }
        if (ph + 1 < p0.ph_hi) xcd_barrier(bar);
    }
}

extern "C" void kernel_launch(void* const* d_in, const int* in_sizes, int n_in, void* d_out, int out_size, void* d_ws, size_t ws_size, hipStream_t stream) {
    static int grid = 0;
    if (grid == 0) {
        if (n_in != 32 || out_size != NTOK * D || ws_size < WS_END) {
            fprintf(stderr, "kernel_launch: unexpected problem: n_in %d out %d ws %zu (need %zu)\n", n_in, out_size, ws_size, (size_t)WS_END);
            grid = -1; return;
        }
        int dev = 0, cus = 0, per_cu = 0;
        hipGetDevice(&dev);
        hipDeviceGetAttribute(&cus, hipDeviceAttributeMultiprocessorCount, dev);
        hipFuncSetAttribute((const void*)mega, hipFuncAttributeMaxDynamicSharedMemorySize, LDS_BYTES);
        hipOccupancyMaxActiveBlocksPerMultiprocessor(&per_cu, (const void*)mega, 512, LDS_BYTES);
        (void)hipGetLastError();
        if (per_cu < 1) { fprintf(stderr, "kernel_launch: occupancy query says %d blocks per CU\n", per_cu); grid = -1; return; }
        grid = cus;
    }
    if (grid < 0) return;
    hipMemsetAsync(d_ws, 0, CTL_BYTES, stream);
    Params p{};
    for (int i = 0; i < 32; ++i) p.in[i] = d_in[i];
    p.out = (float*)d_out; p.ws = (unsigned char*)d_ws;
#if MK_SPLIT
    for (int ph = 0; ph < NPHASE; ++ph) {
        p.ph_lo = ph; p.ph_hi = ph + 1;
        hipLaunchKernelGGL(mega, dim3(grid), dim3(512), LDS_BYTES, stream, p);
    }
#else
    p.ph_lo = 0; p.ph_hi = NPHASE;
    void* args[] = {&p};
    hipError_t e = hipLaunchCooperativeKernel((const void*)mega, dim3(grid), dim3(512), args, LDS_BYTES, stream);
    if (e != hipSuccess) fprintf(stderr, "kernel_launch: cooperative launch failed: %s (grid %d)\n", hipGetErrorString(e), grid);
#endif
    (void)in_sizes;
}
```

```cpp
#include <hip/hip_runtime.h>
#include <cstdint>
#include <cstdio>

#ifndef MK_SPLIT
#define MK_SPLIT 0
#endif

#define DEVFI __device__ __forceinline__
#define LAS __attribute__((address_space(3)))
typedef unsigned short bf16_t;
typedef short bf16x8 __attribute__((ext_vector_type(8)));
typedef float f32x4 __attribute__((ext_vector_type(4)));
typedef float f32x16 __attribute__((ext_vector_type(16)));
typedef short s16x4 __attribute__((ext_vector_type(4)));

constexpr int D = 1024, BATCH = 8, SEQ = 2048, NTOK = BATCH * SEQ, DEPTH = 4;
constexpr int NH = 8, NKV = 2, HD = 64;
constexpr int NCMP = 127;
constexpr int IN_COLS = 3608, ZN = 3840;
constexpr int ZC_Q = 0, ZC_KC = 512, ZC_VC = 640, ZC_KS = 768, ZC_VS = 896, ZC_KW = 1024, ZC_VW = 1152, ZC_U = 1280, ZC_GA = 1536, ZC_GS = 2560, ZC_NG = 3584;
constexpr int SC_NG = 1280, SC_U = 1304, SC_GA = 1560, SC_GS = 2584;
constexpr int NEXP = 32, FF = 512;
constexpr int A_PAD = NTOK * 2 + NEXP * 256;
constexpr float RMS_EPS = 1e-6f;

constexpr size_t al256(size_t x) { return (x + 255) & ~(size_t)255; }
constexpr size_t CTL_BYTES = 65536;
constexpr size_t CTL_CNT = 16384;
constexpr size_t WS_ROPE = CTL_BYTES;
constexpr size_t WS_S5LB = al256(WS_ROPE + (size_t)NTOK * 16 * 4);
constexpr size_t WS_S5BB = al256(WS_S5LB + (size_t)DEPTH * 16 * 64 * 2 * 4);
constexpr size_t WS_CB1 = al256(WS_S5BB + (size_t)DEPTH * 16 * 64 * 16 * 2 * 4);
constexpr size_t WS_WIN = al256(WS_CB1 + (size_t)DEPTH * 2 * 128 * 4);
constexpr size_t WS_CW1 = al256(WS_WIN + (size_t)DEPTH * ZN * 1024 * 2);
constexpr size_t WS_GLU = al256(WS_CW1 + (size_t)DEPTH * 2 * 128 * 2048 * 2);
constexpr size_t WS_PA = al256(WS_GLU + (size_t)DEPTH * 512 * 256 * 2);
constexpr size_t WS_PS = al256(WS_PA + (size_t)DEPTH * 1024 * 512 * 2);
constexpr size_t WS_WO = al256(WS_PS + (size_t)DEPTH * 1024 * 256 * 2);
constexpr size_t WS_EG = al256(WS_WO + (size_t)DEPTH * 1024 * 1024 * 2);
constexpr size_t WS_EU = al256(WS_EG + (size_t)DEPTH * 32 * 512 * 1024 * 2);
constexpr size_t WS_ED = al256(WS_EU + (size_t)DEPTH * 32 * 512 * 1024 * 2);
constexpr size_t WS_H = al256(WS_ED + (size_t)DEPTH * 32 * 1024 * 512 * 2);
constexpr size_t WS_Z = al256(WS_H + (size_t)NTOK * 1024 * 2);
constexpr size_t WS_HID = al256(WS_Z + (size_t)NTOK * ZN * 2);
constexpr size_t WS_KC = al256(WS_HID + (size_t)2 * 2048 * 128 * 2);
constexpr size_t WS_VC = al256(WS_KC + (size_t)BATCH * 2 * 128 * 64 * 4);
constexpr size_t WS_YB = al256(WS_VC + (size_t)BATCH * 2 * 128 * 64 * 4);
constexpr size_t WS_OB = al256(WS_YB + (size_t)NTOK * 256 * 2);
constexpr size_t WS_OA = al256(WS_OB + (size_t)NTOK * 256 * 2);
constexpr size_t WS_OCMP = al256(WS_OA + (size_t)NTOK * 512 * 2);
constexpr size_t WS_SC = al256(WS_OCMP + (size_t)NTOK * 512 * 4);
constexpr size_t WS_PCS = al256(WS_SC + (size_t)BATCH * 2 * SEQ * 128 * 4);
constexpr size_t WS_IMP = al256(WS_PCS + (size_t)BATCH * 2 * SEQ * 128 * 4);
constexpr size_t WS_SEL = al256(WS_IMP + (size_t)BATCH * 2 * SEQ * 32 * 4);
constexpr size_t WS_EID = al256(WS_SEL + (size_t)BATCH * 2 * SEQ * 4);
constexpr size_t WS_EW = al256(WS_EID + (size_t)NTOK * 2 * 4);
constexpr size_t WS_EPOS = al256(WS_EW + (size_t)NTOK * 2 * 4);
constexpr size_t WS_LIST = al256(WS_EPOS + (size_t)NTOK * 2 * 4);
constexpr size_t WS_MRG = al256(WS_LIST + (size_t)32 * NTOK * 4);
constexpr size_t WS_ACT = al256(WS_MRG + (size_t)NTOK * 1024 * 2);
constexpr size_t WS_Y = al256(WS_ACT + (size_t)A_PAD * 512 * 2);
constexpr size_t WS_KCB = al256(WS_Y + (size_t)A_PAD * 1024 * 2);
constexpr size_t WS_VCB = al256(WS_KCB + (size_t)BATCH * 2 * 128 * 64 * 2);
constexpr size_t WS_S5X = WS_MRG;
constexpr size_t WS_END = al256(WS_VCB + (size_t)BATCH * 2 * 128 * 64 * 2);
static_assert(WS_S5X + (size_t)NTOK * 16 * 128 * 4 <= WS_END, "S5X alias must fit");

constexpr int LDS_STAGE = 131072;
constexpr int LDS_CTL = LDS_STAGE;
constexpr int LDS_BYTES = LDS_STAGE + 256;

constexpr int NST = 10;
constexpr int NPHASE = 1 + DEPTH * NST + 1;

struct Params {
    const void* in[32];
    float* out;
    unsigned char* ws;
    int ph_lo, ph_hi;
};
typedef const __attribute__((address_space(4))) Params* KP;

DEVFI int opaque_tid() { int t = threadIdx.x; asm volatile("" : "+v"(t)); return t; }
DEVFI float opaque_zero() { float z = 0.f; asm volatile("" : "+v"(z)); return z; }
DEVFI float bf2f(bf16_t v) { return __uint_as_float((unsigned)v << 16); }
DEVFI unsigned f2bf(float f) { unsigned u = __float_as_uint(f); return (u + 0x7fffu + ((u >> 16) & 1u)) >> 16; }
typedef __bf16 bf16v2_t __attribute__((ext_vector_type(2)));
typedef float f32v2_t __attribute__((ext_vector_type(2)));
DEVFI unsigned pk2(float lo, float hi) { const f32v2_t v = {lo, hi}; return __builtin_bit_cast(unsigned, __builtin_convertvector(v, bf16v2_t)); }
DEVFI float wave_sum(float v) {
#pragma unroll
    for (int o = 1; o < 64; o <<= 1) v += __shfl_xor(v, o);
    return v;
}
DEVFI float sigmoidf_(float x) { return 1.f / (1.f + __expf(-x)); }
DEVFI float gelu_tanh(float x) { return 0.5f * x * (1.f + tanhf(0.7978845608028654f * (x + 0.044715f * x * x * x))); }
DEVFI void unpack8(uint4 v, float* f) {
    f[0] = __uint_as_float(v.x << 16); f[1] = __uint_as_float(v.x & 0xffff0000u);
    f[2] = __uint_as_float(v.y << 16); f[3] = __uint_as_float(v.y & 0xffff0000u);
    f[4] = __uint_as_float(v.z << 16); f[5] = __uint_as_float(v.z & 0xffff0000u);
    f[6] = __uint_as_float(v.w << 16); f[7] = __uint_as_float(v.w & 0xffff0000u);
}

#define XB_TMO      128
#define XB_XCNT(j)  (256  + 64 * (j))
#define XB_XSUB(j)  (1280 + 64 * (j))
#define XB_XGEN(j)  (2304 + 64 * (j))
#define XB_TOP      3328
#define XB_TOPGEN   3392
#define XCD_BAR_WORDS 3456
#define XB_SPIN_CAP (1u << 22)
DEVFI unsigned xb_ld(unsigned* p) { return __hip_atomic_load(p, __ATOMIC_RELAXED, __HIP_MEMORY_SCOPE_AGENT); }
DEVFI unsigned xb_add(unsigned* p, unsigned v) { return __hip_atomic_fetch_add(p, v, __ATOMIC_RELAXED, __HIP_MEMORY_SCOPE_AGENT); }
DEVFI unsigned xb_xcc_id() { return (unsigned)__builtin_amdgcn_s_getreg((3 << 11) | 20) & 0xFu; }
#define XB_SPIN(cond, bar) do { unsigned _sp = 0; while (cond) { __builtin_amdgcn_s_sleep(1); \
    if ((++_sp & 255u) == 0u) { if (xb_ld(&(bar)[XB_TMO])) break; if (_sp > XB_SPIN_CAP) { atomicAdd(&(bar)[XB_TMO], 1u); break; } } } } while (0)
struct XcdBarrier { unsigned* bar; unsigned x; volatile LAS unsigned* st; };
DEVFI XcdBarrier xcd_barrier_post(unsigned* bar, volatile LAS unsigned* st) {
    XcdBarrier b; b.bar = bar; b.x = xb_xcc_id(); b.st = st;
    if (threadIdx.x == 0) (void)xb_add(&bar[XB_XCNT(b.x)], 1u);
    return b;
}
DEVFI void xcd_barrier_complete(unsigned* bar, unsigned x, unsigned& nloc, unsigned& nx) {
    const unsigned G = gridDim.x * gridDim.y * gridDim.z;
    unsigned sum, cnt, mine, sp = 0u;
    for (;;) {
        sum = 0u; cnt = 0u; mine = 0u;
#pragma unroll
        for (unsigned j = 0; j < 16; ++j) { const unsigned c = xb_ld(&bar[XB_XCNT(j)]); sum += c; cnt += (c > 0u) ? 1u : 0u; mine = (j == x) ? c : mine; }
        if (sum == G) break;
        __builtin_amdgcn_s_sleep(1);
        if ((++sp & 255u) == 0u) { if (xb_ld(&bar[XB_TMO])) break; if (sp > XB_SPIN_CAP) { atomicAdd(&bar[XB_TMO], 1u); break; } }
    }
    nloc = mine > 0u ? mine : 1u; nx = cnt > 0u ? cnt : 1u;
}
DEVFI void xcd_barrier(const XcdBarrier& b) {
    asm volatile("s_waitcnt vmcnt(0)" ::: "memory");
    __syncthreads();
    if (threadIdx.x == 0) {
        unsigned* bar = b.bar;
        __builtin_amdgcn_s_waitcnt(0);
        unsigned nloc = b.st[0], nx = b.st[1];
        if (nloc == 0u) { xcd_barrier_complete(bar, b.x, nloc, nx); b.st[0] = nloc; b.st[1] = nx; }
        const unsigned old = xb_add(&bar[XB_XSUB(b.x)], 1u);
        const unsigned gen = old / nloc;
        if (old + 1u == (gen + 1u) * nloc) {
            __builtin_amdgcn_fence(__ATOMIC_RELEASE, "agent");
            asm volatile("s_waitcnt vmcnt(0)" ::: "memory");
            const unsigned og = xb_add(&bar[XB_TOP], 1u);
            const unsigned tg = og / nx;
            if (og + 1u == (tg + 1u) * nx) xb_add(&bar[XB_TOPGEN], 1u);
            else XB_SPIN(xb_ld(&bar[XB_TOPGEN]) == tg, bar);
            __builtin_amdgcn_fence(__ATOMIC_ACQUIRE, "agent");
            xb_add(&bar[XB_XGEN(b.x)], 1u);
            asm volatile("s_waitcnt vmcnt(0)" ::: "memory");
        } else {
            XB_SPIN(xb_ld(&bar[XB_XGEN(b.x)]) == gen, bar);
            __builtin_amdgcn_fence(__ATOMIC_ACQUIRE, "agent");
            asm volatile("s_waitcnt vmcnt(0)" ::: "memory");
        }
    }
    __syncthreads();
}

DEVFI void glds16(const bf16_t* g, unsigned char* l) {
    __builtin_amdgcn_global_load_lds((const unsigned*)g, (unsigned*)l, 16, 0, 0);
}
template <int NB>
DEVFI void gemm_tile(unsigned char* lds, const bf16_t* a0, const bf16_t* a1, int a_kstride,
                     const bf16_t* b0, const bf16_t* b1, int nk, f32x4 (&acc)[NB][4][4]) {
    const int tid = opaque_tid(), lane = tid & 63, wid = tid >> 6;
    const int wr = wid >> 1, wc = wid & 1, fr = lane & 15, fq = lane >> 4;
    constexpr int STAGE = 32768 + NB * 16384;
    const float fz = opaque_zero();
#pragma unroll
    for (int b = 0; b < NB; ++b)
#pragma unroll
        for (int m = 0; m < 4; ++m)
#pragma unroll
            for (int n = 0; n < 4; ++n) acc[b][m][n] = (f32x4){fz, fz, fz, fz};
    auto stage = [&](int kt, int buf) {
        unsigned char* s = lds + buf * STAGE + tid * 16;
        const bf16_t* pa0 = a0 + (size_t)kt * a_kstride;
        const bf16_t* pa1 = a1 + (size_t)kt * a_kstride;
#pragma unroll
        for (int p = 0; p < 2; ++p) {
            glds16(pa0 + p * 32, s + p * 16384);
            glds16(pa1 + p * 32, s + p * 16384 + 8192);
            glds16(b0 + kt * 64 + p * 32, s + 32768 + p * 8192);
            if (NB == 2) glds16(b1 + kt * 64 + p * 32, s + 32768 + 16384 + p * 8192);
        }
    };
    stage(0, 0);
    for (int kt = 0; kt < nk; ++kt) {
        asm volatile("s_waitcnt vmcnt(0)" ::: "memory");
        __syncthreads();
        if (kt + 1 < nk) stage(kt + 1, (kt + 1) & 1);
        const unsigned char* s = lds + (kt & 1) * STAGE;
#pragma unroll
        for (int p = 0; p < 2; ++p) {
            bf16x8 af[4], bfr[NB][4];
#pragma unroll
            for (int m = 0; m < 4; ++m) af[m] = *(const bf16x8*)(s + p * 16384 + (wr * 64 + m * 16 + fr) * 64 + fq * 16);
#pragma unroll
            for (int b = 0; b < NB; ++b)
#pragma unroll
                for (int n = 0; n < 4; ++n) bfr[b][n] = *(const bf16x8*)(s + 32768 + b * 16384 + p * 8192 + (wc * 64 + n * 16 + fr) * 64 + fq * 16);
#pragma unroll
            for (int b = 0; b < NB; ++b)
#pragma unroll
                for (int m = 0; m < 4; ++m)
#pragma unroll
                    for (int n = 0; n < 4; ++n) acc[b][m][n] = __builtin_amdgcn_mfma_f32_16x16x32_bf16(bfr[b][n], af[m], acc[b][m][n], 0, 0, 0);
        }
    }
    __syncthreads();
}

__device__ const double k_rope_consts[10] = {1.0, 0.19392274474868576, 0.03760603093086393, 0.007292664737217109, 0.001414213562373095,
                                             0.0002742481756762073, 5.318295896944988e-05, 1.031338537721246e-05, 6.283185307179586, 0.15915494309189535};
DEVFI void transpose_item(const float* W, int ldw, int n_src0, int ncols, bf16_t* WT, int K, int dst_row0, int k0, float* scr, int lane) {
    const int c = lane & 31; const bool okc = c < ncols;
#pragma unroll 8
    for (int i = 0; i < 32; ++i) { const int kk = 2 * i + (lane >> 5); scr[kk * 33 + c] = okc ? W[(size_t)(k0 + kk) * ldw + n_src0 + c] : 0.f; }
    asm volatile("s_waitcnt lgkmcnt(0)" ::: "memory");
    const int ch = lane & 7;
#pragma unroll
    for (int j = 0; j < 4; ++j) {
        const int n = (lane >> 3) + 8 * j; const float* s = scr + (8 * ch) * 33 + n;
        uint4 o; o.x = pk2(s[0 * 33], s[1 * 33]); o.y = pk2(s[2 * 33], s[3 * 33]); o.z = pk2(s[4 * 33], s[5 * 33]); o.w = pk2(s[6 * 33], s[7 * 33]);
        if (n < ncols) *(uint4*)(WT + (size_t)(dst_row0 + n) * K + k0 + 8 * ch) = o;
    }
    asm volatile("s_waitcnt lgkmcnt(0)" ::: "memory");
}
struct TJob { const float* W; bf16_t* WT; int K, ldw, n_src0, ncols, dst_row0, nb; size_t sstride, dstride; };
DEVFI void run_tjob(const TJob& j, float* scr, int gw, int ngw, int lane) {
    const int nkb = j.K / 64, nnb = (j.ncols + 31) / 32, per = nkb * nnb, total = per * j.nb;
    for (int it = gw; it < total; it += ngw) {
        const int b = it / per, r = it % per, kb = r / nnb, nb = r % nnb;
        const int nc = (j.ncols - nb * 32) < 32 ? (j.ncols - nb * 32) : 32;
        transpose_item(j.W + (size_t)b * j.sstride, j.ldw, j.n_src0 + nb * 32, nc, j.WT + (size_t)b * j.dstride, j.K, j.dst_row0 + nb * 32, kb * 64, scr, lane);
    }
}

DEVFI void phase_prep(KP p, unsigned char* lds) {
    const int tid = opaque_tid(), lane = tid & 63, wid = tid >> 6;
    const int gw = blockIdx.x * 8 + wid, ngw = gridDim.x * 8;
    const int gt = blockIdx.x * 512 + tid, ngt = gridDim.x * 512;
    float* scr = (float*)(lds + wid * 8704);
    unsigned char* ws = p->ws;
    for (int l = 0; l < DEPTH; ++l) {
        const float* win = (const float*)p->in[4] + (size_t)l * 1024 * IN_COLS;
        bf16_t* wint = (bf16_t*)(ws + WS_WIN) + (size_t)l * ZN * 1024;
        TJob j;
        j.nb = 1; j.sstride = 0; j.dstride = 0;
        j.W = win; j.WT = wint; j.K = 1024; j.ldw = IN_COLS;
        j.n_src0 = 0; j.ncols = 1280; j.dst_row0 = 0; run_tjob(j, scr, gw, ngw, lane);
        j.n_src0 = SC_NG; j.ncols = 24; j.dst_row0 = ZC_NG; run_tjob(j, scr, gw, ngw, lane);
        j.n_src0 = SC_U; j.ncols = 256; j.dst_row0 = ZC_U; run_tjob(j, scr, gw, ngw, lane);
        j.n_src0 = SC_GA; j.ncols = 1024; j.dst_row0 = ZC_GA; run_tjob(j, scr, gw, ngw, lane);
        j.n_src0 = SC_GS; j.ncols = 1024; j.dst_row0 = ZC_GS; run_tjob(j, scr, gw, ngw, lane);
        { uint4* z = (uint4*)(wint + (size_t)IN_COLS * 1024); const int n16 = (ZN - IN_COLS) * 1024 * 2 / 16;
          const unsigned uz = __float_as_uint(opaque_zero());
          for (int i = gt; i < n16; i += ngt) z[i] = make_uint4(uz, uz, uz, uz); }
        j.K = 2048; j.ldw = 128; j.n_src0 = 0; j.ncols = 128; j.dst_row0 = 0;
        j.W = (const float*)p->in[8] + (size_t)l * 2048 * 128; j.WT = (bf16_t*)(ws + WS_CW1) + (size_t)(l * 2 + 0) * 128 * 2048; run_tjob(j, scr, gw, ngw, lane);
        j.W = (const float*)p->in[11] + (size_t)l * 2048 * 128; j.WT = (bf16_t*)(ws + WS_CW1) + (size_t)(l * 2 + 1) * 128 * 2048; run_tjob(j, scr, gw, ngw, lane);
        j.K = 256; j.ldw = 512; j.ncols = 512; j.W = (const float*)p->in[21] + (size_t)l * 256 * 512; j.WT = (bf16_t*)(ws + WS_GLU) + (size_t)l * 512 * 256; run_tjob(j, scr, gw, ngw, lane);
        j.K = 512; j.ldw = 1024; j.ncols = 1024; j.W = (const float*)p->in[22] + (size_t)l * 512 * 1024; j.WT = (bf16_t*)(ws + WS_PA) + (size_t)l * 1024 * 512; run_tjob(j, scr, gw, ngw, lane);
        j.K = 256; j.ldw = 1024; j.ncols = 1024; j.W = (const float*)p->in[23] + (size_t)l * 256 * 1024; j.WT = (bf16_t*)(ws + WS_PS) + (size_t)l * 1024 * 256; run_tjob(j, scr, gw, ngw, lane);
        j.K = 1024; j.ldw = 1024; j.ncols = 1024; j.W = (const float*)p->in[24] + (size_t)l * 1024 * 1024; j.WT = (bf16_t*)(ws + WS_WO) + (size_t)l * 1024 * 1024; run_tjob(j, scr, gw, ngw, lane);
        j.nb = 32;
        j.K = 1024; j.ldw = 512; j.ncols = 512; j.sstride = (size_t)1024 * 512; j.dstride = (size_t)512 * 1024;
        j.W = (const float*)p->in[29] + (size_t)l * 32 * 1024 * 512; j.WT = (bf16_t*)(ws + WS_EG) + (size_t)l * 32 * 512 * 1024; run_tjob(j, scr, gw, ngw, lane);
        j.W = (const float*)p->in[30] + (size_t)l * 32 * 1024 * 512; j.WT = (bf16_t*)(ws + WS_EU) + (size_t)l * 32 * 512 * 1024; run_tjob(j, scr, gw, ngw, lane);
        j.K = 512; j.ldw = 1024; j.ncols = 1024; j.sstride = (size_t)512 * 1024; j.dstride = (size_t)1024 * 512;
        j.W = (const float*)p->in[31] + (size_t)l * 32 * 512 * 1024; j.WT = (bf16_t*)(ws + WS_ED) + (size_t)l * 32 * 1024 * 512; run_tjob(j, scr, gw, ngw, lane);
    }
    {
        const int* pos = (const int*)p->in[1]; float* rope = (float*)(ws + WS_ROPE);
        for (int i = gt; i < NTOK * 8; i += ngt) {
            const int n = i >> 3, f = i & 7;
            const double ang = (double)pos[n] * k_rope_consts[f];
            const double r = ang - k_rope_consts[8] * __builtin_rint(ang * k_rope_consts[9]);
            const float rf = (float)r;
            rope[n * 16 + f] = cosf(rf); rope[n * 16 + 8 + f] = sinf(rf);
        }
    }
    {
        float* LB = (float*)(ws + WS_S5LB); float* BB = (float*)(ws + WS_S5BB);
        const float* are = (const float*)p->in[13]; const float* aim = (const float*)p->in[14]; const float* ldt = (const float*)p->in[15];
        const float* bre = (const float*)p->in[16]; const float* bim = (const float*)p->in[17];
        for (int i = gt; i < DEPTH * 16 * 64; i += ngt) {
            const int lg = i >> 6;
            const float lre = fminf(are[i], -1e-4f), lim = aim[i];
            const float dt = expf(ldt[lg]);
            const float a = lre * dt, bq = lim * dt;
            const float em = expm1f(a), cb = cosf(bq), sb = sinf(bq), sh = sinf(0.5f * bq);
            const float lbr = (em + 1.f) * cb, lbi = (em + 1.f) * sb, lm1 = em * cb - 2.f * sh * sh;
            const float den = lre * lre + lim * lim;
            const float fr_ = (lm1 * lre + lbi * lim) / den, fi_ = (lbi * lre - lm1 * lim) / den;
            LB[i * 2] = lbr; LB[i * 2 + 1] = lbi;
            for (int c = 0; c < 16; ++c) {
                const float br = bre[(size_t)i * 16 + c], bi = bim[(size_t)i * 16 + c];
                BB[((size_t)i * 16 + c) * 2] = fr_ * br - fi_ * bi;
                BB[((size_t)i * 16 + c) * 2 + 1] = fr_ * bi + fi_ * br;
            }
        }
    }
    {
        float* CB = (float*)(ws + WS_CB1);
        for (int o = gw; o < DEPTH * 2 * 128; o += ngw) {
            const int l = o >> 8, kv = (o >> 7) & 1, jn = o & 127;
            const float* pe = (const float*)p->in[kv ? 10 : 7] + (size_t)l * 2048;
            const float* w1 = (const float*)p->in[kv ? 11 : 8] + (size_t)l * 2048 * 128;
            float s = 0.f;
            for (int k = lane; k < 2048; k += 64) s += pe[k] * w1[(size_t)k * 128 + jn];
            s = wave_sum(s);
            if (lane == 0) CB[o] = s;
        }
    }
}

DEVFI int seg_start_lane(const int* cnt, int lane) {
    const int c = (lane < 32) ? cnt[lane] : 0;
    const int pad = (c + 255) & ~255;
    int incl = pad;
#pragma unroll
    for (int o = 1; o < 32; o <<= 1) { const int v = __shfl_up(incl, o); if ((lane & 31) >= o) incl += v; }
    return incl - pad;
}

DEVFI void stage_norm1(KP p, int l, bool final_only) {
    const int tid = opaque_tid(), lane = tid & 63, wid = tid >> 6;
    const int gw = blockIdx.x * 8 + wid, ngw = gridDim.x * 8;
    unsigned char* ws = p->ws;
    const float* xin = (const float*)p->in[0];
    float* xres = p->out;
    bf16_t* H = (bf16_t*)(ws + WS_H);
    const bf16_t* Y = (const bf16_t*)(ws + WS_Y);
    const int* eid = (const int*)(ws + WS_EID); const float* ew = (const float*)(ws + WS_EW); const int* epos = (const int*)(ws + WS_EPOS);
    int segs = 0;
    if (l > 0) segs = seg_start_lane((const int*)(ws + CTL_CNT) + (l - 1) * 32, lane);
    const float* gain = final_only ? nullptr : (const float*)p->in[2] + (size_t)l * 1024;
    for (int row = gw; row < NTOK; row += ngw) {
        f32x4 v[4];
        if (l == 0) {
#pragma unroll
            for (int j = 0; j < 4; ++j) v[j] = *(const f32x4*)(xin + (size_t)row * 1024 + lane * 4 + 256 * j);
        } else {
            const int e0 = eid[row * 2], e1 = eid[row * 2 + 1];
            const float w0 = ew[row * 2], w1 = ew[row * 2 + 1];
            const int s0 = __shfl(segs, e0) + epos[row * 2], s1 = __shfl(segs, e1) + epos[row * 2 + 1];
#pragma unroll
            for (int j = 0; j < 4; ++j) {
                v[j] = *(const f32x4*)(xres + (size_t)row * 1024 + lane * 4 + 256 * j);
                const uint2 ya = *(const uint2*)(Y + (size_t)s0 * 1024 + lane * 4 + 256 * j);
                const uint2 yb = *(const uint2*)(Y + (size_t)s1 * 1024 + lane * 4 + 256 * j);
                float a0 = __uint_as_float(ya.x << 16), a1 = __uint_as_float(ya.x & 0xffff0000u), a2 = __uint_as_float(ya.y << 16), a3 = __uint_as_float(ya.y & 0xffff0000u);
                float b0 = __uint_as_float(yb.x << 16), b1 = __uint_as_float(yb.x & 0xffff0000u), b2 = __uint_as_float(yb.y << 16), b3 = __uint_as_float(yb.y & 0xffff0000u);
                v[j][0] += w0 * a0 + w1 * b0; v[j][1] += w0 * a1 + w1 * b1; v[j][2] += w0 * a2 + w1 * b2; v[j][3] += w0 * a3 + w1 * b3;
            }
        }
#pragma unroll
        for (int j = 0; j < 4; ++j) *(f32x4*)(xres + (size_t)row * 1024 + lane * 4 + 256 * j) = v[j];
        if (final_only) continue;
        float ss = 0.f;
#pragma unroll
        for (int j = 0; j < 4; ++j) ss += v[j][0] * v[j][0] + v[j][1] * v[j][1] + v[j][2] * v[j][2] + v[j][3] * v[j][3];
        ss = wave_sum(ss);
        const float rstd = rsqrtf(ss * (1.f / 1024.f) + RMS_EPS);
#pragma unroll
        for (int j = 0; j < 4; ++j) {
            const f32x4 g = *(const f32x4*)(gain + lane * 4 + 256 * j);
            uint2 o; o.x = pk2(v[j][0] * rstd * g[0], v[j][1] * rstd * g[1]); o.y = pk2(v[j][2] * rstd * g[2], v[j][3] * rstd * g[3]);
            *(uint2*)(H + (size_t)row * 1024 + lane * 4 + 256 * j) = o;
        }
    }
}

DEVFI void stage_inproj(KP p, int l, unsigned char* lds) {
    const int tid = opaque_tid(), lane = tid & 63, wid = tid >> 6, wr = wid >> 1, wc = wid & 1, fr = lane & 15, fq = lane >> 4;
    unsigned char* ws = p->ws;
    const bf16_t* H = (const bf16_t*)(ws + WS_H);
    const bf16_t* W = (const bf16_t*)(ws + WS_WIN) + (size_t)l * ZN * 1024;
    bf16_t* Z = (bf16_t*)(ws + WS_Z);
    constexpr int NMT = NTOK / 256, NNT = ZN / 128;
    for (int u = blockIdx.x; u < NMT * NNT; u += gridDim.x) {
        const int mt = u % NMT, nt = u / NMT;
        const bf16_t* a0 = H + (size_t)(mt * 256 + (tid >> 2)) * 1024 + (tid & 3) * 8;
        const bf16_t* a1 = a0 + (size_t)128 * 1024;
        const bf16_t* b0 = W + (size_t)(nt * 128 + (tid >> 2)) * 1024 + (tid & 3) * 8;
        f32x4 acc[1][4][4];
        gemm_tile<1>(lds, a0, a1, 64, b0, nullptr, 16, acc);
#pragma unroll
        for (int m = 0; m < 4; ++m)
#pragma unroll
            for (int n = 0; n < 4; ++n) {
                const int row = mt * 256 + wr * 64 + m * 16 + fr, col = nt * 128 + wc * 64 + n * 16 + fq * 4;
                uint2 o; o.x = pk2(acc[0][m][n][0], acc[0][m][n][1]); o.y = pk2(acc[0][m][n][2], acc[0][m][n][3]);
                *(uint2*)(Z + (size_t)row * ZN + col) = o;
            }
    }
}

DEVFI void stage_posta(KP p, int l, unsigned char* lds) {
    const int tid = opaque_tid(), lane = tid & 63, wid = tid >> 6, wr = wid >> 1, wc = wid & 1, fr = lane & 15, fq = lane >> 4;
    const int gw = blockIdx.x * 8 + wid, ngw = gridDim.x * 8;
    const int gt = blockIdx.x * 512 + tid, ngt = gridDim.x * 512;
    unsigned char* ws = p->ws;
    bf16_t* Z = (bf16_t*)(ws + WS_Z);
    {
        const float* LB = (const float*)(ws + WS_S5LB) + (size_t)l * 16 * 64 * 2;
        const float* BB = (const float*)(ws + WS_S5BB) + (size_t)l * 16 * 64 * 16 * 2;
        float* X = (float*)(ws + WS_S5X);
        for (int item = blockIdx.x; item < BATCH * 16; item += gridDim.x) {
            if (wid != 0) continue;
            const int b = item >> 4, g = item & 15;
            const float lbr = LB[(g * 64 + lane) * 2], lbi = LB[(g * 64 + lane) * 2 + 1];
            float br[16], bi[16];
#pragma unroll
            for (int c = 0; c < 16; ++c) { br[c] = BB[((size_t)(g * 64 + lane) * 16 + c) * 2]; bi[c] = BB[((size_t)(g * 64 + lane) * 16 + c) * 2 + 1]; }
            float xr = 0.f, xi = 0.f;
            for (int t = 0; t < SEQ; ++t) {
                const bf16_t* up = Z + (size_t)(b * SEQ + t) * ZN + ZC_U + g * 16;
                const uint4 u0 = *(const uint4*)up, u1 = *(const uint4*)(up + 8);
                float u[16]; unpack8(u0, u); unpack8(u1, u + 8);
                float ar = 0.f, ai = 0.f;
#pragma unroll
                for (int c = 0; c < 16; ++c) { ar += br[c] * u[c]; ai += bi[c] * u[c]; }
                const float nr = lbr * xr - lbi * xi + ar, ni = lbr * xi + lbi * xr + ai;
                xr = nr; xi = ni;
                *(float2*)(X + ((size_t)(b * SEQ + t) * 16 + g) * 128 + lane * 2) = make_float2(xr, xi);
            }
        }
    }
    {
        const float* rope = (const float*)(ws + WS_ROPE);
        const float* qg = (const float*)p->in[5] + l * 64; const float* kg = (const float*)p->in[6] + l * 64;
        for (int i = gt; i < NTOK * 12; i += ngt) {
            const int n = i / 12, hs = i % 12;
            const int col = hs < 8 ? ZC_Q + hs * 64 : (hs < 10 ? ZC_KS + (hs - 8) * 64 : ZC_KW + (hs - 10) * 64);
            const float* gn = hs < 8 ? qg : kg;
            bf16_t* zp = Z + (size_t)n * ZN + col;
            float v[64];
#pragma unroll
            for (int j = 0; j < 8; ++j) unpack8(*(const uint4*)(zp + j * 8), v + j * 8);
            float ss = 0.f;
#pragma unroll
            for (int j = 0; j < 64; ++j) ss += v[j] * v[j];
            const float rstd = rsqrtf(ss * (1.f / 64.f) + RMS_EPS);
#pragma unroll
            for (int j = 0; j < 64; ++j) v[j] = v[j] * rstd * gn[j];
#pragma unroll
            for (int f = 0; f < 8; ++f) {
                const float c = rope[n * 16 + f], s = rope[n * 16 + 8 + f];
                const float x1 = v[f], x2 = v[8 + f];
                v[f] = x1 * c - x2 * s; v[8 + f] = x2 * c + x1 * s;
            }
#pragma unroll
            for (int j = 0; j < 8; ++j) {
                uint4 o; o.x = pk2(v[j * 8], v[j * 8 + 1]); o.y = pk2(v[j * 8 + 2], v[j * 8 + 3]); o.z = pk2(v[j * 8 + 4], v[j * 8 + 5]); o.w = pk2(v[j * 8 + 6], v[j * 8 + 7]);
                *(uint4*)(zp + j * 8) = o;
            }
        }
    }
    {
        const bf16_t* W1 = (const bf16_t*)(ws + WS_CW1) + (size_t)l * 2 * 128 * 2048;
        const float* CB = (const float*)(ws + WS_CB1) + l * 256;
        bf16_t* HID = (bf16_t*)(ws + WS_HID);
        constexpr int MR = BATCH * 2 * NCMP;
        for (int uu = (int)((blockIdx.x + gridDim.x / 2) % gridDim.x); uu < 16; uu += gridDim.x) {
            const int u = uu;
            const int kv = u >> 3, mt = u & 7;
            auto rowptr = [&](int r) -> const bf16_t* {
                if (r >= MR) r = MR - 1;
                const int bh = r / NCMP, c = r % NCMP, b = bh >> 1, hk = bh & 1;
                return Z + (size_t)(b * SEQ + 16 * c) * ZN + (kv ? ZC_VC : ZC_KC) + hk * 64;
            };
            const bf16_t* a0 = rowptr(mt * 256 + (tid >> 2)) + (tid & 3) * 8;
            const bf16_t* a1 = rowptr(mt * 256 + 128 + (tid >> 2)) + (tid & 3) * 8;
            const bf16_t* b0 = W1 + (size_t)kv * 128 * 2048 + (size_t)(tid >> 2) * 2048 + (tid & 3) * 8;
            f32x4 acc[1][4][4];
            gemm_tile<1>(lds, a0, a1, ZN, b0, nullptr, 32, acc);
#pragma unroll
            for (int m = 0; m < 4; ++m)
#pragma unroll
                for (int n = 0; n < 4; ++n) {
                    const int row = mt * 256 + wr * 64 + m * 16 + fr, col = wc * 64 + n * 16 + fq * 4;
                    float o[4];
#pragma unroll
                    for (int r = 0; r < 4; ++r) o[r] = gelu_tanh(acc[0][m][n][r] + CB[kv * 128 + col + r]);
                    uint2 w; w.x = pk2(o[0], o[1]); w.y = pk2(o[2], o[3]);
                    if (row < MR) *(uint2*)(HID + ((size_t)kv * 2048 + row) * 128 + col) = w;
                }
        }
    }
    (void)gw; (void)ngw;
}

DEVFI void stage_postb(KP p, int l) {
    const int tid = opaque_tid();
    const int gt = blockIdx.x * 512 + tid, ngt = gridDim.x * 512;
    unsigned char* ws = p->ws;
    {
        const bf16_t* HID = (const bf16_t*)(ws + WS_HID);
        const float* rope = (const float*)(ws + WS_ROPE);
        const float* kg = (const float*)p->in[6] + l * 64;
        constexpr int MR = BATCH * 2 * NCMP;
        for (int i = gt; i < 2 * MR; i += ngt) {
            const int kv = i / MR, r = i % MR;
            const int bh = r / NCMP, c = r % NCMP, b = bh >> 1;
            const float* w2 = (const float*)p->in[kv ? 12 : 9] + (size_t)l * 128 * 64;
            const bf16_t* hp = HID + ((size_t)kv * 2048 + r) * 128;
            float o[64];
#pragma unroll
            for (int d = 0; d < 64; ++d) o[d] = 0.f;
            for (int k8 = 0; k8 < 16; ++k8) {
                float hv[8]; unpack8(*(const uint4*)(hp + k8 * 8), hv);
#pragma unroll
                for (int kk = 0; kk < 8; ++kk) {
                    const float* wrow = w2 + (size_t)(k8 * 8 + kk) * 64;
#pragma unroll
                    for (int d = 0; d < 64; ++d) o[d] += hv[kk] * wrow[d];
                }
            }
            float* dst = (float*)(ws + (kv ? WS_VC : WS_KC)) + ((size_t)bh * 128 + c) * 64;
            if (kv == 0) {
                float ss = 0.f;
#pragma unroll
                for (int d = 0; d < 64; ++d) ss += o[d] * o[d];
                const float rstd = rsqrtf(ss * (1.f / 64.f) + RMS_EPS);
#pragma unroll
                for (int d = 0; d < 64; ++d) o[d] = o[d] * rstd * kg[d];
                const int n = b * SEQ + 16 * c + 31;
#pragma unroll
                for (int f = 0; f < 8; ++f) {
                    const float cs = rope[n * 16 + f], sn = rope[n * 16 + 8 + f];
                    const float x1 = o[f], x2 = o[8 + f];
                    o[f] = x1 * cs - x2 * sn; o[8 + f] = x2 * cs + x1 * sn;
                }
            }
            bf16_t* dstb = (bf16_t*)(ws + (kv ? WS_VCB : WS_KCB)) + ((size_t)bh * 128 + c) * 64;
#pragma unroll
            for (int d = 0; d < 64; d += 8) {
                uint4 w; w.x = pk2(o[d], o[d + 1]); w.y = pk2(o[d + 2], o[d + 3]); w.z = pk2(o[d + 4], o[d + 5]); w.w = pk2(o[d + 6], o[d + 7]);
                *(uint4*)(dstb + d) = w;
                if (c == 0) *(uint4*)(dstb + 127 * 64 + d) = make_uint4(0u, 0u, 0u, 0u);
            }
            (void)dst;
        }
    }
    {
        const int tid = opaque_tid();
        const int gt = blockIdx.x * 512 + tid, ngt = gridDim.x * 512;
        const float* X = (const float*)(ws + WS_S5X);
        const float* cre = (const float*)p->in[18] + (size_t)l * 16 * 16 * 64; const float* cim = (const float*)p->in[19] + (size_t)l * 16 * 16 * 64;
        const float* dsk = (const float*)p->in[20] + l * 256;
        const bf16_t* Z = (const bf16_t*)(ws + WS_Z);
        bf16_t* YB = (bf16_t*)(ws + WS_YB);
        for (int i = gt; i < NTOK * 256; i += ngt) {
            const int n = i >> 8, gc = i & 255, g = gc >> 4;
            const float* xp = X + ((size_t)n * 16 + g) * 128;
            const float* cr = cre + (size_t)gc * 64; const float* ci = cim + (size_t)gc * 64;
            float y = 0.f;
            for (int pq = 0; pq < 64; pq += 2) {
                const f32x4 xv = *(const f32x4*)(xp + pq * 2);
                y += xv[0] * cr[pq] - xv[1] * ci[pq] + xv[2] * cr[pq + 1] - xv[3] * ci[pq + 1];
            }
            y += dsk[gc] * bf2f(Z[(size_t)n * ZN + ZC_U + gc]);
            YB[(size_t)n * 256 + gc] = (bf16_t)f2bf(gelu_tanh(y));
        }
    }
}


DEVFI bf16x8 pack8(const f32x16& v, const int o) {
    const unsigned a = pk2(v[o], v[o + 1]), b = pk2(v[o + 2], v[o + 3]), c = pk2(v[o + 4], v[o + 5]), d = pk2(v[o + 6], v[o + 7]);
    typedef unsigned u32x4 __attribute__((ext_vector_type(4)));
    const u32x4 w = {a, b, c, d};
    return __builtin_bit_cast(bf16x8, w);
}
DEVFI bf16x8 tr_read2(const unsigned char* p) {
    LAS s16x4* q = (LAS s16x4*)(LAS unsigned char*)p;
    const s16x4 a = __builtin_amdgcn_ds_read_tr16_b64_v4i16(q);
    const s16x4 b = __builtin_amdgcn_ds_read_tr16_b64_v4i16(q + 64);
    return (bf16x8){a[0], a[1], a[2], a[3], b[0], b[1], b[2], b[3]};
}
#define KK(reg) (((reg) & 3) + 8 * ((reg) >> 2))
DEVFI void stage_attn(KP p, int l, unsigned char* lds) {
    const int tid = opaque_tid(), lane = tid & 63, wid = tid >> 6, r = lane & 31, h = lane >> 5;
    unsigned char* ws = p->ws;
    const bf16_t* Z = (const bf16_t*)(ws + WS_Z);
    const bf16_t* KCb = (const bf16_t*)(ws + WS_KCB); const bf16_t* VCb = (const bf16_t*)(ws + WS_VCB);
    bf16_t* OA = (bf16_t*)(ws + WS_OA);
    constexpr float SC = 0.125f * 1.4426950408889634f;
    unsigned char* ring = lds; unsigned char* kcl = lds + 32768; unsigned char* vcl = lds + 49152;
    const int xsw = (r >> 2) & 3;
    const int ksl0 = ((0 + h) ^ xsw) * 16, ksl1 = ((2 + h) ^ xsw) * 16;
    const int vlo = (4 * h + ((r & 15) >> 2)) * 64 + ((r >> 4) * 16 + 4 * (r & 3)) * 2;
    const float fz = opaque_zero();
#define ZERO16_LIT ((f32x16){0.f, 0.f, 0.f, 0.f, 0.f, 0.f, 0.f, 0.f, 0.f, 0.f, 0.f, 0.f, 0.f, 0.f, 0.f, 0.f})
#define ZERO16_FZ ((f32x16){fz, fz, fz, fz, fz, fz, fz, fz, fz, fz, fz, fz, fz, fz, fz, fz})
    const int s_pan = tid >> 8, s_key = (tid >> 2) & 63, s_cs = tid & 3, s_kc = s_cs ^ ((s_key >> 2) & 3);
    const int c_key = tid >> 2, c_kc = s_cs ^ ((c_key >> 2) & 3);
    for (int pair = blockIdx.x; pair < 256; pair += gridDim.x) {
        const int bh = pair >> 4, ap = pair & 15, b = bh >> 1, hk = bh & 1;
#pragma unroll 1
        for (int ui = 0; ui < 2; ++ui) {
            const int a = ui == 0 ? 31 - ap : ap;
            const int t0 = 64 * a;
            const int tok = t0 + 8 * wid + (r >> 2), g = r & 3, hq = hk * 4 + g;
            const bf16_t* zrow = Z + (size_t)(b * SEQ + tok) * ZN;
            const int nslc = a + 1, jw0 = a > 8 ? a - 8 : 0, nsteps = nslc + (a - jw0 + 1);
            auto stage_kv = [&](int st, int buf) {
                const bool slc = st < nslc; const int j = slc ? st : jw0 + (st - nslc);
                const bf16_t* src = Z + (size_t)(b * SEQ + 64 * j + s_key) * ZN + hk * 64 + s_pan * 32;
                glds16(src + (slc ? ZC_KS : ZC_KW) + s_kc * 8, ring + buf * 16384 + tid * 16);
                glds16(src + (slc ? ZC_VS : ZC_VW) + s_cs * 8, ring + buf * 16384 + 8192 + tid * 16);
            };
#pragma unroll
            for (int part = 0; part < 2; ++part) {
                glds16(KCb + ((size_t)bh * 128 + c_key) * 64 + part * 32 + c_kc * 8, kcl + part * 8192 + tid * 16);
                glds16(VCb + ((size_t)bh * 128 + c_key) * 64 + part * 32 + s_cs * 8, vcl + part * 8192 + tid * 16);
            }
            stage_kv(0, 0);
            bf16x8 Qf[4];
#pragma unroll
            for (int ks = 0; ks < 4; ++ks) Qf[ks] = *(const bf16x8*)(zrow + ZC_Q + hq * 64 + 16 * ks + 8 * h);
            const float g0 = sigmoidf_(bf2f(zrow[ZC_NG + hq * 3])), g1 = sigmoidf_(bf2f(zrow[ZC_NG + hq * 3 + 1])), g2 = sigmoidf_(bf2f(zrow[ZC_NG + hq * 3 + 2]));
            asm volatile("s_waitcnt vmcnt(0)" ::: "memory");
            __syncthreads();
            f32x16 res[2];
            unsigned selmask;
            {
                f32x16 sc[4];
#pragma unroll
                for (int kt = 0; kt < 4; ++kt) {
                    sc[kt] = ZERO16_LIT;
#pragma unroll
                    for (int ks = 0; ks < 4; ++ks) {
                        const bf16x8 kf = *(const bf16x8*)(kcl + (ks >> 1) * 8192 + (32 * kt + r) * 64 + ((ks & 1) ? ksl1 : ksl0));
                        sc[kt] = __builtin_amdgcn_mfma_f32_32x32x16_bf16(kf, Qf[ks], sc[kt], 0, 0, 0);
                    }
                }
                const int ncv = tok >= 31 ? ((tok - 31) >> 4) + 1 : 0;
                const int cb = ncv - 4 * h;
                float mx = -1e30f;
#pragma unroll
                for (int kt = 0; kt < 4; ++kt)
#pragma unroll
                    for (int reg = 0; reg < 16; ++reg) { const float v = (32 * kt + KK(reg) < cb) ? sc[kt][reg] * SC : -1e30f; sc[kt][reg] = v; mx = fmaxf(mx, v); }
                mx = fmaxf(mx, __shfl_xor(mx, 32));
                float sum = 0.f;
#pragma unroll
                for (int kt = 0; kt < 4; ++kt)
#pragma unroll
                    for (int reg = 0; reg < 16; ++reg) { const float v = sc[kt][reg]; const float pv = v > -1e29f ? __builtin_amdgcn_exp2f(v - mx) : 0.f; sc[kt][reg] = pv; sum += pv; }
                sum += __shfl_xor(sum, 32);
                const float inv = sum > 0.f ? 1.f / sum : 0.f;
#pragma unroll
                for (int kt = 0; kt < 4; ++kt) sc[kt] = sc[kt] * inv;
                f32x16 oc[2]; oc[0] = ZERO16_LIT; oc[1] = ZERO16_LIT;
#pragma unroll
                for (int sp = 0; sp < 8; ++sp) {
                    const bf16x8 pf = pack8(sc[sp >> 1], 8 * (sp & 1));
#pragma unroll
                    for (int dt = 0; dt < 2; ++dt) {
                        const bf16x8 vf = tr_read2(vcl + dt * 8192 + 16 * sp * 64 + vlo);
                        oc[dt] = __builtin_amdgcn_mfma_f32_32x32x16_bf16(vf, pf, oc[dt], 0, 0, 0);
                    }
                }
                res[0] = oc[0] * g0; res[1] = oc[1] * g0;
                float imp[16], lastv[16];
#pragma unroll
                for (int i = 0; i < 16; ++i) { const int kt = i >> 2, q = i & 3; imp[i] = (sc[kt][4 * q] + sc[kt][4 * q + 1]) + (sc[kt][4 * q + 2] + sc[kt][4 * q + 3]); lastv[i] = sc[kt][4 * q + 3]; }
                {
                    float recv[16];
#pragma unroll
                    for (int i = 0; i < 16; ++i) recv[i] = __shfl_xor(lastv[i], 32);
#pragma unroll
                    for (int i = 0; i < 16; ++i) { const float pl = i >= 1 ? recv[i - 1] : 0.f; imp[i] += h ? recv[i] : pl; }
                }
#pragma unroll
                for (int i = 0; i < 16; ++i) { imp[i] += __shfl_xor(imp[i], 1); imp[i] += __shfl_xor(imp[i], 2); }
#pragma unroll
                for (int i = 0; i < 16; ++i) { const int j = 2 * i + h; imp[i] = (j == 0 || j == a || j == a - 1) ? __builtin_inff() : (j > a ? -__builtin_inff() : imp[i]); }
                float* itab = (float*)(lds + 65536) + (8 * wid + (r >> 2)) * 32;
                if (g == 0) {
#pragma unroll
                    for (int i = 0; i < 16; ++i) itab[2 * i + h] = imp[i];
                }
                asm volatile("s_waitcnt lgkmcnt(0)" ::: "memory");
                const int sub = g + 4 * h;
                const f32x4 mine = *(const f32x4*)(itab + 4 * sub);
                int rk0 = 0, rk1 = 0, rk2 = 0, rk3 = 0;
#pragma unroll
                for (int m4 = 0; m4 < 8; ++m4) {
                    const f32x4 vv = *(const f32x4*)(itab + 4 * m4);
#pragma unroll
                    for (int e = 0; e < 4; ++e) {
                        const float vm = vv[e]; const int mi = 4 * m4 + e;
                        rk0 += (int)(vm > mine[0]) | ((int)(vm == mine[0]) & (int)(mi < 4 * sub + 0));
                        rk1 += (int)(vm > mine[1]) | ((int)(vm == mine[1]) & (int)(mi < 4 * sub + 1));
                        rk2 += (int)(vm > mine[2]) | ((int)(vm == mine[2]) & (int)(mi < 4 * sub + 2));
                        rk3 += (int)(vm > mine[3]) | ((int)(vm == mine[3]) & (int)(mi < 4 * sub + 3));
                    }
                }
                unsigned mm = ((rk0 < 16 ? 1u : 0u) | (rk1 < 16 ? 2u : 0u) | (rk2 < 16 ? 4u : 0u) | (rk3 < 16 ? 8u : 0u)) << (4 * sub);
                mm |= (unsigned)__shfl_xor((int)mm, 1); mm |= (unsigned)__shfl_xor((int)mm, 2);
                selmask = mm | (unsigned)__shfl_xor((int)mm, 32);
            }
            f32x16 O[2]; O[0] = ZERO16_FZ; O[1] = ZERO16_FZ;
            float mrun = -1e30f, lpart = fz;
#pragma unroll 1
            for (int st = 0; st < nsteps; ++st) {
                asm volatile("s_waitcnt vmcnt(0)" ::: "memory");
                __syncthreads();
                if (st + 1 < nsteps) stage_kv(st + 1, (st + 1) & 1);
                const bool slc = st < nslc; const int j = slc ? st : jw0 + (st - nslc);
                const unsigned char* kb = ring + (st & 1) * 16384; const unsigned char* vb = kb + 8192;
                f32x16 sc[2];
#pragma unroll
                for (int kt = 0; kt < 2; ++kt) {
                    sc[kt] = ZERO16_LIT;
#pragma unroll
                    for (int ks = 0; ks < 4; ++ks) {
                        const bf16x8 kf = *(const bf16x8*)(kb + (ks >> 1) * 4096 + (32 * kt + r) * 64 + ((ks & 1) ? ksl1 : ksl0));
                        sc[kt] = __builtin_amdgcn_mfma_f32_32x32x16_bf16(kf, Qf[ks], sc[kt], 0, 0, 0);
                    }
                }
                const int base = tok - 64 * j - 4 * h;
                const bool rowok = slc ? ((selmask >> j) & 1u) != 0u : true;
                const unsigned hiu = slc ? 0x7fffffffu : 511u;
                float bm = -1e30f;
#pragma unroll
                for (int kt = 0; kt < 2; ++kt)
#pragma unroll
                    for (int reg = 0; reg < 16; ++reg) {
                        const bool ok = rowok && ((unsigned)(base - (32 * kt + KK(reg))) <= hiu);
                        const float v = ok ? sc[kt][reg] * SC : -1e30f; sc[kt][reg] = v; bm = fmaxf(bm, v);
                    }
                bm = fmaxf(bm, __shfl_xor(bm, 32));
                const float mn = fmaxf(mrun, bm), alpha = __builtin_amdgcn_exp2f(mrun - mn);
                mrun = mn;
                float ps = 0.f;
#pragma unroll
                for (int kt = 0; kt < 2; ++kt)
#pragma unroll
                    for (int reg = 0; reg < 16; ++reg) { const float v = sc[kt][reg]; const float pv = v > -1e29f ? __builtin_amdgcn_exp2f(v - mn) : 0.f; sc[kt][reg] = pv; ps += pv; }
                lpart = lpart * alpha + ps;
                O[0] = O[0] * alpha; O[1] = O[1] * alpha;
#pragma unroll
                for (int sp = 0; sp < 4; ++sp) {
                    const bf16x8 pf = pack8(sc[sp >> 1], 8 * (sp & 1));
#pragma unroll
                    for (int dt = 0; dt < 2; ++dt) {
                        const bf16x8 vf = tr_read2(vb + dt * 4096 + 16 * sp * 64 + vlo);
                        O[dt] = __builtin_amdgcn_mfma_f32_32x32x16_bf16(vf, pf, O[dt], 0, 0, 0);
                    }
                }
                if (st == nslc - 1 || st == nsteps - 1) {
                    const float lt = lpart + __shfl_xor(lpart, 32);
                    const float gsc = (st == nslc - 1 ? g1 : g2) / lt;
                    res[0] = res[0] + O[0] * gsc; res[1] = res[1] + O[1] * gsc;
                    O[0] = ZERO16_FZ; O[1] = ZERO16_FZ; mrun = -1e30f; lpart = fz;
                }
            }
            bf16_t* orow = OA + (size_t)(b * SEQ + tok) * 512 + hq * 64 + 4 * h;
#pragma unroll
            for (int dt = 0; dt < 2; ++dt)
#pragma unroll
                for (int q = 0; q < 4; ++q) {
                    uint2 w; w.x = pk2(res[dt][4 * q], res[dt][4 * q + 1]); w.y = pk2(res[dt][4 * q + 2], res[dt][4 * q + 3]);
                    *(uint2*)(orow + 32 * dt + 8 * q) = w;
                }
            __syncthreads();
        }
    }
    (void)l;
}

DEVFI void stage_glu(KP p, int l, unsigned char* lds) {
    const int tid = opaque_tid(), lane = tid & 63, wid = tid >> 6, wr = wid >> 1, wc = wid & 1, fr = lane & 15, fq = lane >> 4;
    unsigned char* ws = p->ws;
    {
        const bf16_t* YB = (const bf16_t*)(ws + WS_YB);
        const bf16_t* G = (const bf16_t*)(ws + WS_GLU) + (size_t)l * 512 * 256;
        bf16_t* OB = (bf16_t*)(ws + WS_OB);
        for (int u = blockIdx.x; u < 64 * 4; u += gridDim.x) {
            const int mt = u >> 2, nt = u & 3;
            const bf16_t* a0 = YB + (size_t)(mt * 256 + (tid >> 2)) * 256 + (tid & 3) * 8;
            const bf16_t* a1 = a0 + (size_t)128 * 256;
            const int brow = tid >> 2, sub = brow >> 4;
            const bf16_t* b0 = G + (size_t)((sub & 1) * 256 + nt * 64 + (sub >> 1) * 16 + (brow & 15)) * 256 + (tid & 3) * 8;
            f32x4 acc[1][4][4];
            gemm_tile<1>(lds, a0, a1, 64, b0, nullptr, 4, acc);
#pragma unroll
            for (int m = 0; m < 4; ++m)
#pragma unroll
                for (int n = 0; n < 4; n += 2) {
                    const int row = mt * 256 + wr * 64 + m * 16 + fr, col = nt * 64 + (wc * 2 + (n >> 1)) * 16 + fq * 4;
                    float o[4];
#pragma unroll
                    for (int r = 0; r < 4; ++r) o[r] = acc[0][m][n][r] * sigmoidf_(acc[0][m][n + 1][r]);
                    uint2 w; w.x = pk2(o[0], o[1]); w.y = pk2(o[2], o[3]);
                    *(uint2*)(OB + (size_t)row * 256 + col) = w;
                }
        }
    }
}

DEVFI void stage_merge(KP p, int l, unsigned char* lds) {
    const int tid = opaque_tid(), lane = tid & 63, wid = tid >> 6, wr = wid >> 1, wc = wid & 1, fr = lane & 15, fq = lane >> 4;
    unsigned char* ws = p->ws;
    const bf16_t* OA = (const bf16_t*)(ws + WS_OA); const bf16_t* OB = (const bf16_t*)(ws + WS_OB);
    const bf16_t* PA = (const bf16_t*)(ws + WS_PA) + (size_t)l * 1024 * 512; const bf16_t* PS = (const bf16_t*)(ws + WS_PS) + (size_t)l * 1024 * 256;
    const bf16_t* Z = (const bf16_t*)(ws + WS_Z);
    bf16_t* MRG = (bf16_t*)(ws + WS_MRG);
    for (int u = blockIdx.x; u < 64 * 8; u += gridDim.x) {
        const int mt = u & 63, nt = u >> 6;
        f32x4 acc1[1][4][4], acc2[1][4][4];
        {
            const bf16_t* a0 = OA + (size_t)(mt * 256 + (tid >> 2)) * 512 + (tid & 3) * 8;
            const bf16_t* b0 = PA + (size_t)(nt * 128 + (tid >> 2)) * 512 + (tid & 3) * 8;
            gemm_tile<1>(lds, a0, a0 + (size_t)128 * 512, 64, b0, nullptr, 8, acc1);
        }
        {
            const bf16_t* a0 = OB + (size_t)(mt * 256 + (tid >> 2)) * 256 + (tid & 3) * 8;
            const bf16_t* b0 = PS + (size_t)(nt * 128 + (tid >> 2)) * 256 + (tid & 3) * 8;
            gemm_tile<1>(lds, a0, a0 + (size_t)128 * 256, 64, b0, nullptr, 4, acc2);
        }
#pragma unroll
        for (int m = 0; m < 4; ++m)
#pragma unroll
            for (int n = 0; n < 4; ++n) {
                const int row = mt * 256 + wr * 64 + m * 16 + fr, col = nt * 128 + wc * 64 + n * 16 + fq * 4;
                const uint2 ga = *(const uint2*)(Z + (size_t)row * ZN + ZC_GA + col), gs = *(const uint2*)(Z + (size_t)row * ZN + ZC_GS + col);
                const float a[4] = {__uint_as_float(ga.x << 16), __uint_as_float(ga.x & 0xffff0000u), __uint_as_float(ga.y << 16), __uint_as_float(ga.y & 0xffff0000u)};
                const float s[4] = {__uint_as_float(gs.x << 16), __uint_as_float(gs.x & 0xffff0000u), __uint_as_float(gs.y << 16), __uint_as_float(gs.y & 0xffff0000u)};
                float o[4];
#pragma unroll
                for (int r = 0; r < 4; ++r) o[r] = sigmoidf_(a[r]) * acc1[0][m][n][r] + sigmoidf_(s[r]) * acc2[0][m][n][r];
                uint2 w; w.x = pk2(o[0], o[1]); w.y = pk2(o[2], o[3]);
                *(uint2*)(MRG + (size_t)row * 1024 + col) = w;
            }
    }
}

DEVFI void stage_out(KP p, int l, unsigned char* lds) {
    const int tid = opaque_tid(), lane = tid & 63, wid = tid >> 6, wr = wid >> 1, wc = wid & 1, fr = lane & 15, fq = lane >> 4;
    unsigned char* ws = p->ws;
    const bf16_t* MRG = (const bf16_t*)(ws + WS_MRG);
    const bf16_t* WO = (const bf16_t*)(ws + WS_WO) + (size_t)l * 1024 * 1024;
    float* xres = p->out;
    for (int u = blockIdx.x; u < 64 * 8; u += gridDim.x) {
        const int mt = u & 63, nt = u >> 6;
        const bf16_t* a0 = MRG + (size_t)(mt * 256 + (tid >> 2)) * 1024 + (tid & 3) * 8;
        const bf16_t* b0 = WO + (size_t)(nt * 128 + (tid >> 2)) * 1024 + (tid & 3) * 8;
        f32x4 acc[1][4][4];
        gemm_tile<1>(lds, a0, a0 + (size_t)128 * 1024, 64, b0, nullptr, 16, acc);
#pragma unroll
        for (int m = 0; m < 4; ++m)
#pragma unroll
            for (int n = 0; n < 4; ++n) {
                const int row = mt * 256 + wr * 64 + m * 16 + fr, col = nt * 128 + wc * 64 + n * 16 + fq * 4;
                float* xp = xres + (size_t)row * 1024 + col;
                *(f32x4*)xp = *(const f32x4*)xp + acc[0][m][n];
            }
    }
}

DEVFI void stage_route(KP p, int l) {
    const int tid = opaque_tid(), lane = tid & 63, wid = tid >> 6;
    const int gw = blockIdx.x * 8 + wid, ngw = gridDim.x * 8;
    unsigned char* ws = p->ws;
    const float* xres = p->out;
    bf16_t* H = (bf16_t*)(ws + WS_H);
    const float* gain = (const float*)p->in[3] + (size_t)l * 1024;
    const float* wrg = (const float*)p->in[25] + (size_t)l * 1024 * 4; const float* brg = (const float*)p->in[26] + l * 4;
    const float* wre = (const float*)p->in[27] + (size_t)l * 1024 * 32; const float* bre = (const float*)p->in[28] + l * 32;
    int* cnt = (int*)(ws + CTL_CNT) + l * 32;
    int* eid = (int*)(ws + WS_EID); float* ew = (float*)(ws + WS_EW); int* epos = (int*)(ws + WS_EPOS); int* list = (int*)(ws + WS_LIST);
    for (int row = gw; row < NTOK; row += ngw) {
        f32x4 v[4]; float ss = 0.f;
#pragma unroll
        for (int j = 0; j < 4; ++j) { v[j] = *(const f32x4*)(xres + (size_t)row * 1024 + lane * 4 + 256 * j); ss += v[j][0] * v[j][0] + v[j][1] * v[j][1] + v[j][2] * v[j][2] + v[j][3] * v[j][3]; }
        ss = wave_sum(ss);
        const float rstd = rsqrtf(ss * (1.f / 1024.f) + RMS_EPS);
        float lg[36];
#pragma unroll
        for (int o = 0; o < 36; ++o) lg[o] = 0.f;
#pragma unroll
        for (int j = 0; j < 4; ++j) {
            const f32x4 g = *(const f32x4*)(gain + lane * 4 + 256 * j);
            float hn[4];
#pragma unroll
            for (int r = 0; r < 4; ++r) hn[r] = v[j][r] * rstd * g[r];
            uint2 o; o.x = pk2(hn[0], hn[1]); o.y = pk2(hn[2], hn[3]);
            *(uint2*)(H + (size_t)row * 1024 + lane * 4 + 256 * j) = o;
#pragma unroll
            for (int r = 0; r < 4; ++r) {
                const int k = lane * 4 + 256 * j + r;
                const f32x4 wg = *(const f32x4*)(wrg + (size_t)k * 4);
#pragma unroll
                for (int o4 = 0; o4 < 4; ++o4) lg[o4] += hn[r] * wg[o4];
#pragma unroll
                for (int o8 = 0; o8 < 8; ++o8) {
                    const f32x4 we = *(const f32x4*)(wre + (size_t)k * 32 + o8 * 4);
                    lg[4 + o8 * 4] += hn[r] * we[0]; lg[5 + o8 * 4] += hn[r] * we[1]; lg[6 + o8 * 4] += hn[r] * we[2]; lg[7 + o8 * 4] += hn[r] * we[3];
                }
            }
        }
#pragma unroll
        for (int o = 0; o < 36; ++o) lg[o] = wave_sum(lg[o]);
        float gl[4];
#pragma unroll
        for (int i = 0; i < 4; ++i) gl[i] = lg[i] + brg[i];
        int gs = 0; float gm = gl[0];
#pragma unroll
        for (int i = 1; i < 4; ++i) if (gl[i] > gm) { gm = gl[i]; gs = i; }
        float gsum = 0.f;
#pragma unroll
        for (int i = 0; i < 4; ++i) gsum += __expf(gl[i] - gm);
        const float gwt = 1.f / gsum;
        float el[8];
#pragma unroll
        for (int i = 0; i < 8; ++i) {
            const float a = gs == 0 ? lg[4 + i] : (gs == 1 ? lg[12 + i] : (gs == 2 ? lg[20 + i] : lg[28 + i]));
            el[i] = a + bre[gs * 8 + i];
        }
        int i1 = 0; float m1 = el[0];
#pragma unroll
        for (int i = 1; i < 8; ++i) if (el[i] > m1) { m1 = el[i]; i1 = i; }
        int i2 = -1; float m2 = -__builtin_inff();
#pragma unroll
        for (int i = 0; i < 8; ++i) if (i != i1 && el[i] > m2) { m2 = el[i]; i2 = i; }
        const float e2 = __expf(m2 - m1);
        const float w1 = gwt / (1.f + e2), w2 = gwt * e2 / (1.f + e2);
        if (lane == 0) {
            const int ea = gs * 8 + i1, eb = gs * 8 + i2;
            const int pa = atomicAdd(cnt + ea, 1), pb = atomicAdd(cnt + eb, 1);
            eid[row * 2] = ea; eid[row * 2 + 1] = eb; ew[row * 2] = w1; ew[row * 2 + 1] = w2; epos[row * 2] = pa; epos[row * 2 + 1] = pb;
            list[ea * NTOK + pa] = row; list[eb * NTOK + pb] = row;
        }
    }
}

DEVFI bool find_tile(const int* cnt, int ti, int& e, int& mt, int& segstart, int& ecnt) {
    int acc_t = 0, acc_s = 0;
    for (int i = 0; i < 32; ++i) {
        const int c = cnt[i], nt = (c + 255) >> 8;
        if (ti < acc_t + nt) { e = i; mt = ti - acc_t; segstart = acc_s; ecnt = c; return true; }
        acc_t += nt; acc_s += nt << 8;
    }
    return false;
}

DEVFI void stage_gateup(KP p, int l, unsigned char* lds) {
    const int tid = opaque_tid(), lane = tid & 63, wid = tid >> 6, wr = wid >> 1, wc = wid & 1, fr = lane & 15, fq = lane >> 4;
    unsigned char* ws = p->ws;
    const bf16_t* H = (const bf16_t*)(ws + WS_H);
    const bf16_t* EG = (const bf16_t*)(ws + WS_EG) + (size_t)l * 32 * 512 * 1024; const bf16_t* EU = (const bf16_t*)(ws + WS_EU) + (size_t)l * 32 * 512 * 1024;
    const int* cnt = (const int*)(ws + CTL_CNT) + l * 32;
    const int* list = (const int*)(ws + WS_LIST);
    bf16_t* ACT = (bf16_t*)(ws + WS_ACT);
    for (int u = blockIdx.x;; u += gridDim.x) {
        const int ti = u >> 3, nt = u & 7;
        int e, mt, seg, ec;
        if (!find_tile(cnt, ti, e, mt, seg, ec)) break;
        int r0 = mt * 256 + (tid >> 2), r1 = r0 + 128;
        if (r0 >= ec) r0 = 0;
        if (r1 >= ec) r1 = 0;
        const int tk0 = list[e * NTOK + r0], tk1 = list[e * NTOK + r1];
        const bf16_t* a0 = H + (size_t)tk0 * 1024 + (tid & 3) * 8;
        const bf16_t* a1 = H + (size_t)tk1 * 1024 + (tid & 3) * 8;
        const int brow = tid >> 2, sub = brow >> 4;
        const bf16_t* b0 = ((sub & 1) ? EU : EG) + ((size_t)e * 512 + nt * 64 + (sub >> 1) * 16 + (brow & 15)) * 1024 + (tid & 3) * 8;
        f32x4 acc[1][4][4];
        gemm_tile<1>(lds, a0, a1, 64, b0, nullptr, 16, acc);
#pragma unroll
        for (int m = 0; m < 4; ++m)
#pragma unroll
            for (int n = 0; n < 4; n += 2) {
                const int slot = seg + mt * 256 + wr * 64 + m * 16 + fr, col = nt * 64 + (wc * 2 + (n >> 1)) * 16 + fq * 4;
                float o[4];
#pragma unroll
                for (int r = 0; r < 4; ++r) { const float g = acc[0][m][n][r]; o[r] = g * sigmoidf_(g) * acc[0][m][n + 1][r]; }
                uint2 w; w.x = pk2(o[0], o[1]); w.y = pk2(o[2], o[3]);
                *(uint2*)(ACT + (size_t)slot * 512 + col) = w;
            }
    }
}

DEVFI void stage_down(KP p, int l, unsigned char* lds) {
    const int tid = opaque_tid(), lane = tid & 63, wid = tid >> 6, wr = wid >> 1, wc = wid & 1, fr = lane & 15, fq = lane >> 4;
    unsigned char* ws = p->ws;
    const bf16_t* ACT = (const bf16_t*)(ws + WS_ACT);
    const bf16_t* ED = (const bf16_t*)(ws + WS_ED) + (size_t)l * 32 * 1024 * 512;
    const int* cnt = (const int*)(ws + CTL_CNT) + l * 32;
    bf16_t* Y = (bf16_t*)(ws + WS_Y);
    for (int u = blockIdx.x;; u += gridDim.x) {
        const int ti = u >> 3, nt = u & 7;
        int e, mt, seg, ec;
        if (!find_tile(cnt, ti, e, mt, seg, ec)) break;
        const bf16_t* a0 = ACT + (size_t)(seg + mt * 256 + (tid >> 2)) * 512 + (tid & 3) * 8;
        const bf16_t* b0 = ED + ((size_t)e * 1024 + nt * 128 + (tid >> 2)) * 512 + (tid & 3) * 8;
        f32x4 acc[1][4][4];
        gemm_tile<1>(lds, a0, a0 + (size_t)128 * 512, 64, b0, nullptr, 8, acc);
#pragma unroll
        for (int m = 0; m < 4; ++m)
#pragma unroll
            for (int n = 0; n < 4; ++n) {
                const int slot = seg + mt * 256 + wr * 64 + m * 16 + fr, col = nt * 128 + wc * 64 + n * 16 + fq * 4;
                uint2 w; w.x = pk2(acc[0][m][n][0], acc[0][m][n][1]); w.y = pk2(acc[0][m][n][2], acc[0][m][n][3]);
                *(uint2*)(Y + (size_t)slot * 1024 + col) = w;
            }
    }
}

__global__ void __launch_bounds__(512) mega(Params p0) {
    extern __shared__ __attribute__((aligned(16))) unsigned char lds[];
    volatile LAS unsigned* ctl = (volatile LAS unsigned*)(LAS unsigned char*)(lds + LDS_CTL);
    if (threadIdx.x < 64) ctl[threadIdx.x] = 0u;
    __syncthreads();
    XcdBarrier bar; bar.bar = (unsigned*)p0.ws; bar.x = 0; bar.st = ctl;
    const bool multi = (p0.ph_hi - p0.ph_lo) > 1;
    if (multi) bar = xcd_barrier_post((unsigned*)p0.ws, ctl);
    for (int ph = p0.ph_lo; ph < p0.ph_hi; ++ph) {
        KP p = (KP)__builtin_amdgcn_kernarg_segment_ptr();
        asm volatile("" : "+s"(p));
#ifndef ONLY
#define ONLY -1
#endif
#ifndef SKIP
#define SKIP -1
#endif
#define RUN(k) ((ONLY < 0 || ONLY == (k)) && SKIP != (k))
        if (ph == 0) { if (RUN(100)) phase_prep(p, lds); }
        else if (ph == NPHASE - 1) { if (RUN(0)) stage_norm1(p, DEPTH, true); }
        else {
            const int l = (ph - 1) / NST, s = (ph - 1) % NST;
            switch (s) {
                case 0: if (RUN(0)) stage_norm1(p, l, false); break;
                case 1: if (RUN(1)) stage_inproj(p, l, lds); break;
                case 2: if (RUN(2)) stage_posta(p, l, lds); break;
                case 3: if (RUN(3)) stage_postb(p, l); break;
                case 4: if (RUN(4)) { stage_attn(p, l, lds); stage_glu(p, l, lds); } break;
                case 5: if (RUN(6)) stage_merge(p, l, lds); break;
                case 6: if (RUN(7)) stage_out(p, l, lds); break;
                case 7: if (RUN(8)) stage_route(p, l); break;
                case 8: if (RUN(9)) stage_gateup(p, l, lds); break;
                default: if (RUN(10)) stage_down(p, l, lds); break;
            }
        }
        if (ph + 1 < p0.ph_hi) xcd_barrier(bar);
    }
}

extern "C" void kernel_launch(void* const* d_in, const int* in_sizes, int n_in, void* d_out, int out_size, void* d_ws, size_t ws_size, hipStream_t stream) {
    static int grid = 0;
    if (grid == 0) {
        if (n_in != 32 || out_size != NTOK * D || ws_size < WS_END) {
            fprintf(stderr, "kernel_launch: unexpected problem: n_in %d out %d ws %zu (need %zu)\n", n_in, out_size, ws_size, (size_t)WS_END);
            grid = -1; return;
        }
        int dev = 0, cus = 0, per_cu = 0;
        hipGetDevice(&dev);
        hipDeviceGetAttribute(&cus, hipDeviceAttributeMultiprocessorCount, dev);
        hipFuncSetAttribute((const void*)mega, hipFuncAttributeMaxDynamicSharedMemorySize, LDS_BYTES);
        hipOccupancyMaxActiveBlocksPerMultiprocessor(&per_cu, (const void*)mega, 512, LDS_BYTES);
        (void)hipGetLastError();
        if (per_cu < 1) { fprintf(stderr, "kernel_launch: occupancy query says %d blocks per CU\n", per_cu); grid = -1; return; }
        grid = cus;
    }
    if (grid < 0) return;
    hipMemsetAsync(d_ws, 0, CTL_BYTES, stream);
    Params p{};
    for (int i = 0; i < 32; ++i) p.in[i] = d_in[i];
    p.out = (float*)d_out; p.ws = (unsigned char*)d_ws;
#if MK_SPLIT
    for (int ph = 0; ph < NPHASE; ++ph) {
        p.ph_lo = ph; p.ph_hi = ph + 1;
        hipLaunchKernelGGL(mega, dim3(grid), dim3(512), LDS_BYTES, stream, p);
    }
#else
    p.ph_lo = 0; p.ph_hi = NPHASE;
    void* args[] = {&p};
    hipError_t e = hipLaunchCooperativeKernel((const void*)mega, dim3(grid), dim3(512), args, LDS_BYTES, stream);
    if (e != hipSuccess) fprintf(stderr, "kernel_launch: cooperative launch failed: %s (grid %d)\n", hipGetErrorString(e), grid);
#endif
    (void)in_sizes;
}
```

```cpp
#include <hip/hip_runtime.h>
#include <cstdint>
#include <cstdio>

#ifndef PROBE_MASK
#define PROBE_INNER 0
#define PROBE_MASK 0
#endif
#ifndef MK_SPLIT
#define MK_SPLIT 0
#endif

#define DEVFI __device__ __forceinline__
#define LAS __attribute__((address_space(3)))
typedef unsigned short bf16_t;
typedef short bf16x8 __attribute__((ext_vector_type(8)));
typedef float f32x4 __attribute__((ext_vector_type(4)));
typedef float f32x16 __attribute__((ext_vector_type(16)));
typedef short s16x4 __attribute__((ext_vector_type(4)));

constexpr int D = 1024, BATCH = 8, SEQ = 2048, NTOK = BATCH * SEQ, DEPTH = 4;
constexpr int NH = 8, NKV = 2, HD = 64;
constexpr int NCMP = 127;
constexpr int IN_COLS = 3608, ZN = 3840;
constexpr int ZC_Q = 0, ZC_KC = 512, ZC_VC = 640, ZC_KS = 768, ZC_VS = 896, ZC_KW = 1024, ZC_VW = 1152, ZC_U = 1280, ZC_GA = 1536, ZC_GS = 2560, ZC_NG = 3584;
constexpr int SC_NG = 1280, SC_U = 1304, SC_GA = 1560, SC_GS = 2584;
constexpr int NEXP = 32, FF = 512;
constexpr int A_PAD = NTOK * 2 + NEXP * 256;
constexpr float RMS_EPS = 1e-6f;

constexpr size_t al256(size_t x) { return (x + 255) & ~(size_t)255; }
constexpr size_t CTL_BYTES = 65536;
constexpr size_t CTL_CNT = 16384;
constexpr size_t WS_ROPE = CTL_BYTES;
constexpr size_t WS_S5LB = al256(WS_ROPE + (size_t)NTOK * 16 * 4);
constexpr size_t WS_S5BB = al256(WS_S5LB + (size_t)DEPTH * 16 * 64 * 2 * 4);
constexpr size_t WS_CB1 = al256(WS_S5BB + (size_t)DEPTH * 16 * 64 * 16 * 2 * 4);
constexpr size_t WS_WIN = al256(WS_CB1 + (size_t)DEPTH * 2 * 128 * 4);
constexpr size_t WS_CW1 = al256(WS_WIN + (size_t)DEPTH * ZN * 1024 * 2);
constexpr size_t WS_GLU = al256(WS_CW1 + (size_t)DEPTH * 2 * 128 * 2048 * 2);
constexpr size_t WS_PA = al256(WS_GLU + (size_t)DEPTH * 512 * 256 * 2);
constexpr size_t WS_PS = al256(WS_PA + (size_t)DEPTH * 1024 * 512 * 2);
constexpr size_t WS_WO = al256(WS_PS + (size_t)DEPTH * 1024 * 256 * 2);
constexpr size_t WS_EG = al256(WS_WO + (size_t)DEPTH * 1024 * 1024 * 2);
constexpr size_t WS_EU = al256(WS_EG + (size_t)DEPTH * 32 * 512 * 1024 * 2);
constexpr size_t WS_ED = al256(WS_EU + (size_t)DEPTH * 32 * 512 * 1024 * 2);
constexpr size_t WS_H = al256(WS_ED + (size_t)DEPTH * 32 * 1024 * 512 * 2);
constexpr size_t WS_Z = al256(WS_H + (size_t)NTOK * 1024 * 2);
constexpr size_t WS_HID = al256(WS_Z + (size_t)NTOK * ZN * 2);
constexpr size_t WS_KC = al256(WS_HID + (size_t)2 * 2048 * 128 * 2);
constexpr size_t WS_VC = al256(WS_KC + (size_t)BATCH * 2 * 128 * 64 * 4);
constexpr size_t WS_YB = al256(WS_VC + (size_t)BATCH * 2 * 128 * 64 * 4);
constexpr size_t WS_OB = al256(WS_YB + (size_t)NTOK * 256 * 2);
constexpr size_t WS_OA = al256(WS_OB + (size_t)NTOK * 256 * 2);
constexpr size_t WS_OCMP = al256(WS_OA + (size_t)NTOK * 512 * 2);
constexpr size_t WS_POW = WS_OCMP;
constexpr size_t WS_KTAB = al256(WS_POW + (size_t)DEPTH * 16 * 64 * 65 * 8);
constexpr size_t WS_CW2T = al256(WS_KTAB + (size_t)DEPTH * 16 * 66 * 256 * 2);
static_assert(al256(WS_CW2T + (size_t)DEPTH * 2 * 64 * 128 * 2) <= WS_OCMP + (size_t)NTOK * 512 * 4, "S5 tables fit the old OCMP region");
constexpr size_t WS_SC = al256(WS_OCMP + (size_t)NTOK * 512 * 4);
constexpr size_t WS_MSTATE = WS_SC;
constexpr size_t WS_PCS = al256(WS_SC + (size_t)BATCH * 2 * SEQ * 128 * 4);
constexpr size_t WS_MCARRY = WS_PCS;
constexpr size_t WS_IMP = al256(WS_PCS + (size_t)BATCH * 2 * SEQ * 128 * 4);
constexpr size_t WS_RSTD = WS_IMP;
constexpr size_t WS_WRT = al256(WS_RSTD + (size_t)2 * NTOK * 4);
static_assert(WS_WRT + (size_t)DEPTH * 48 * 1024 * 4 <= WS_IMP + (size_t)BATCH * 2 * SEQ * 32 * 4, "fits the old IMP region");
constexpr size_t WS_SEL = al256(WS_IMP + (size_t)BATCH * 2 * SEQ * 32 * 4);
constexpr size_t WS_EID = al256(WS_SEL + (size_t)BATCH * 2 * SEQ * 4);
constexpr size_t WS_EW = al256(WS_EID + (size_t)NTOK * 2 * 4);
constexpr size_t WS_EPOS = al256(WS_EW + (size_t)NTOK * 2 * 4);
constexpr size_t WS_LIST = al256(WS_EPOS + (size_t)NTOK * 2 * 4);
constexpr size_t WS_MRG = al256(WS_LIST + (size_t)32 * NTOK * 4);
constexpr size_t WS_ACT = al256(WS_MRG + (size_t)NTOK * 1024 * 2);
constexpr size_t WS_Y = al256(WS_ACT + (size_t)A_PAD * 512 * 2);
constexpr size_t WS_KCB = al256(WS_Y + (size_t)A_PAD * 1024 * 2);
constexpr size_t WS_VCB = al256(WS_KCB + (size_t)BATCH * 2 * 128 * 64 * 2);
constexpr size_t WS_S5X = WS_MRG;
constexpr size_t WS_END = al256(WS_VCB + (size_t)BATCH * 2 * 128 * 64 * 2);
static_assert(WS_S5X + (size_t)NTOK * 16 * 128 * 4 <= WS_END, "S5X alias must fit");

constexpr int LDS_STAGE = 147456;
constexpr int LDS_CTL = LDS_STAGE;
constexpr int LDS_BYTES = LDS_STAGE + 256;

constexpr int NST = 9;
constexpr int NPRE = 2;
constexpr int NPHASE = NPRE + DEPTH * NST + 1;

struct Params {
    const void* in[32];
    float* out;
    unsigned char* ws;
    int ph_lo, ph_hi;
};
typedef const __attribute__((address_space(4))) Params* KP;

DEVFI int opaque_tid() { int t = threadIdx.x; asm volatile("" : "+v"(t)); return t; }
DEVFI float opaque_zero() { float z = 0.f; asm volatile("" : "+v"(z)); return z; }
DEVFI float bf2f(bf16_t v) { return __uint_as_float((unsigned)v << 16); }
DEVFI unsigned f2bf(float f) { unsigned u = __float_as_uint(f); return (u + 0x7fffu + ((u >> 16) & 1u)) >> 16; }
typedef __bf16 bf16v2_t __attribute__((ext_vector_type(2)));
typedef float f32v2_t __attribute__((ext_vector_type(2)));
DEVFI unsigned pk2(float lo, float hi) { const f32v2_t v = {lo, hi}; return __builtin_bit_cast(unsigned, __builtin_convertvector(v, bf16v2_t)); }
DEVFI float wave_sum(float v) {
#pragma unroll
    for (int o = 1; o < 64; o <<= 1) v += __shfl_xor(v, o);
    return v;
}
DEVFI float sigmoidf_(float x) { return 1.f / (1.f + __expf(-x)); }
DEVFI float gelu_tanh(float x) { return 0.5f * x * (1.f + tanhf(0.7978845608028654f * (x + 0.044715f * x * x * x))); }
DEVFI void unpack8(uint4 v, float* f) {
    f[0] = __uint_as_float(v.x << 16); f[1] = __uint_as_float(v.x & 0xffff0000u);
    f[2] = __uint_as_float(v.y << 16); f[3] = __uint_as_float(v.y & 0xffff0000u);
    f[4] = __uint_as_float(v.z << 16); f[5] = __uint_as_float(v.z & 0xffff0000u);
    f[6] = __uint_as_float(v.w << 16); f[7] = __uint_as_float(v.w & 0xffff0000u);
}

#define XB_TMO      128
#define XB_XCNT(j)  (256  + 64 * (j))
#define XB_XSUB(j)  (1280 + 64 * (j))
#define XB_XGEN(j)  (2304 + 64 * (j))
#define XB_TOP      3328
#define XB_TOPGEN   3392
#define XCD_BAR_WORDS 3456
#define XB_SPIN_CAP (1u << 22)
DEVFI unsigned xb_ld(unsigned* p) { return __hip_atomic_load(p, __ATOMIC_RELAXED, __HIP_MEMORY_SCOPE_AGENT); }
DEVFI unsigned xb_add(unsigned* p, unsigned v) { return __hip_atomic_fetch_add(p, v, __ATOMIC_RELAXED, __HIP_MEMORY_SCOPE_AGENT); }
DEVFI unsigned xb_xcc_id() { return (unsigned)__builtin_amdgcn_s_getreg((3 << 11) | 20) & 0xFu; }
#define XB_SPIN(cond, bar) do { unsigned _sp = 0; while (cond) { __builtin_amdgcn_s_sleep(1); \
    if ((++_sp & 255u) == 0u) { if (xb_ld(&(bar)[XB_TMO])) break; if (_sp > XB_SPIN_CAP) { atomicAdd(&(bar)[XB_TMO], 1u); break; } } } } while (0)
struct XcdBarrier { unsigned* bar; unsigned x; volatile LAS unsigned* st; };
DEVFI XcdBarrier xcd_barrier_post(unsigned* bar, volatile LAS unsigned* st) {
    XcdBarrier b; b.bar = bar; b.x = xb_xcc_id(); b.st = st;
    if (threadIdx.x == 0) (void)xb_add(&bar[XB_XCNT(b.x)], 1u);
    return b;
}
DEVFI void xcd_barrier_complete(unsigned* bar, unsigned x, unsigned& nloc, unsigned& nx) {
    const unsigned G = gridDim.x * gridDim.y * gridDim.z;
    unsigned sum, cnt, mine, sp = 0u;
    for (;;) {
        sum = 0u; cnt = 0u; mine = 0u;
#pragma unroll
        for (unsigned j = 0; j < 16; ++j) { const unsigned c = xb_ld(&bar[XB_XCNT(j)]); sum += c; cnt += (c > 0u) ? 1u : 0u; mine = (j == x) ? c : mine; }
        if (sum == G) break;
        __builtin_amdgcn_s_sleep(1);
        if ((++sp & 255u) == 0u) { if (xb_ld(&bar[XB_TMO])) break; if (sp > XB_SPIN_CAP) { atomicAdd(&bar[XB_TMO], 1u); break; } }
    }
    nloc = mine > 0u ? mine : 1u; nx = cnt > 0u ? cnt : 1u;
}
DEVFI void xcd_barrier(const XcdBarrier& b) {
    asm volatile("s_waitcnt vmcnt(0)" ::: "memory");
    __syncthreads();
    if (threadIdx.x == 0) {
        unsigned* bar = b.bar;
        __builtin_amdgcn_s_waitcnt(0);
        unsigned nloc = b.st[0], nx = b.st[1];
        if (nloc == 0u) { xcd_barrier_complete(bar, b.x, nloc, nx); b.st[0] = nloc; b.st[1] = nx; }
        const unsigned old = xb_add(&bar[XB_XSUB(b.x)], 1u);
        const unsigned gen = old / nloc;
        if (old + 1u == (gen + 1u) * nloc) {
            __builtin_amdgcn_fence(__ATOMIC_RELEASE, "agent");
            asm volatile("s_waitcnt vmcnt(0)" ::: "memory");
            const unsigned og = xb_add(&bar[XB_TOP], 1u);
            const unsigned tg = og / nx;
            if (og + 1u == (tg + 1u) * nx) xb_add(&bar[XB_TOPGEN], 1u);
            else XB_SPIN(xb_ld(&bar[XB_TOPGEN]) == tg, bar);
            __builtin_amdgcn_fence(__ATOMIC_ACQUIRE, "agent");
            xb_add(&bar[XB_XGEN(b.x)], 1u);
            asm volatile("s_waitcnt vmcnt(0)" ::: "memory");
        } else {
            XB_SPIN(xb_ld(&bar[XB_XGEN(b.x)]) == gen, bar);
            __builtin_amdgcn_fence(__ATOMIC_ACQUIRE, "agent");
            asm volatile("s_waitcnt vmcnt(0)" ::: "memory");
        }
    }
    __syncthreads();
}

#define SWZ_CHUNK(tid) ((((tid) & 3) ^ ((((tid) >> 5) & 1) << 1)) * 8)
DEVFI void glds16(const bf16_t* g, unsigned char* l) {
    __builtin_amdgcn_global_load_lds((const unsigned*)g, (unsigned*)l, 16, 0, 0);
}
template <int NB>
DEVFI void gemm_tile(unsigned char* lds, const bf16_t* a0, const bf16_t* a1, int a_kstride,
                     const bf16_t* b0, const bf16_t* b1, int nk, f32x4 (&acc)[NB][4][4]) {
    static_assert(NB == 1, "three-stage ring is sized for one B tile");
    const int tid = opaque_tid(), lane = tid & 63, wid = tid >> 6;
    const int wr = wid >> 1, wc = wid & 1, fr = lane & 15, fq = lane >> 4;
    const int fsw = (fq ^ (((fr >> 3) & 1) << 1)) * 16;
    constexpr int STAGE = 32768 + 16384;
    const float fz = opaque_zero();
#pragma unroll
    for (int m = 0; m < 4; ++m)
#pragma unroll
        for (int n = 0; n < 4; ++n) acc[0][m][n] = (f32x4){fz, fz, fz, fz};
    auto stage = [&](int kt, int buf) {
        unsigned char* s = lds + buf * STAGE + tid * 16;
        const bf16_t* pa0 = a0 + (size_t)kt * a_kstride;
        const bf16_t* pa1 = a1 + (size_t)kt * a_kstride;
#pragma unroll
        for (int pq = 0; pq < 2; ++pq) {
            glds16(pa0 + pq * 32, s + pq * 16384);
            glds16(pa1 + pq * 32, s + pq * 16384 + 8192);
            glds16(b0 + kt * 64 + pq * 32, s + 32768 + pq * 8192);
        }
    };
    stage(0, 0);
    if (nk > 1) stage(1, 1);
    int buf = 0;
    for (int kt = 0; kt < nk; ++kt) {
        if (kt + 1 < nk) asm volatile("s_waitcnt vmcnt(6)" ::: "memory"); else asm volatile("s_waitcnt vmcnt(0)" ::: "memory");
        __builtin_amdgcn_s_barrier();
        asm volatile("" ::: "memory");
        if (kt + 2 < nk) { const int nb = buf >= 1 ? buf - 1 : 2; stage(kt + 2, nb); }
        const unsigned char* s = lds + buf * STAGE;
#pragma unroll
        for (int pq = 0; pq < 2; ++pq) {
            bf16x8 af[4], bfr[4];
#pragma unroll
            for (int m = 0; m < 4; ++m) af[m] = *(const bf16x8*)(s + pq * 16384 + (wr * 64 + m * 16 + fr) * 64 + fsw);
#pragma unroll
            for (int n = 0; n < 4; ++n) bfr[n] = *(const bf16x8*)(s + 32768 + pq * 8192 + (wc * 64 + n * 16 + fr) * 64 + fsw);
#pragma unroll
            for (int m = 0; m < 4; ++m)
#pragma unroll
                for (int n = 0; n < 4; ++n) acc[0][m][n] = __builtin_amdgcn_mfma_f32_16x16x32_bf16(bfr[n], af[m], acc[0][m][n], 0, 0, 0);
        }
        buf = buf == 2 ? 0 : buf + 1;
    }
    asm volatile("s_waitcnt lgkmcnt(0)" ::: "memory");
    __builtin_amdgcn_s_barrier();
    asm volatile("" ::: "memory");
    (void)b1;
}

#ifndef PROBE_INNER
#define PROBE_INNER 0
#endif
DEVFI void gemm_tile8(unsigned char* lds, const bf16_t* a0, const bf16_t* a1, const bf16_t* b0, const bf16_t* b1, int nk, f32x4 (&acc)[8][4]) {
#if PROBE_INNER
    const unsigned long long pi_t0 = __builtin_amdgcn_s_memrealtime();
#endif
    const int tid = opaque_tid(), lane = tid & 63, wid = tid >> 6;
    const int wr = wid >> 2, wc = wid & 3, fr = lane & 15, fq = lane >> 4;
    const int fsw = (fq ^ (((fr >> 3) & 1) << 1)) * 16;
    constexpr int STAGE = 32768;
    const float fz = opaque_zero();
#pragma unroll
    for (int m = 0; m < 8; ++m)
#pragma unroll
        for (int n = 0; n < 4; ++n) acc[m][n] = (f32x4){fz, fz, fz, fz};
    auto stage = [&](int kt, int buf) {
        unsigned char* s = lds + buf * STAGE + tid * 16;
        glds16(a0 + kt * 32, s);
        glds16(a1 + kt * 32, s + 8192);
        glds16(b0 + kt * 32, s + 16384);
        glds16(b1 + kt * 32, s + 16384 + 8192);
    };
    stage(0, 0);
    if (nk > 1) stage(1, 1);
    if (nk > 2) stage(2, 2);
    for (int kt = 0; kt < nk; ++kt) {
        if (kt + 2 < nk) asm volatile("s_waitcnt vmcnt(8)" ::: "memory");
        else if (kt + 1 < nk) asm volatile("s_waitcnt vmcnt(4)" ::: "memory");
        else asm volatile("s_waitcnt vmcnt(0)" ::: "memory");
        __builtin_amdgcn_s_barrier();
        asm volatile("" ::: "memory");
        if (kt + 3 < nk) stage(kt + 3, (kt + 3) & 3);
        const unsigned char* s = lds + (kt & 3) * STAGE;
        bf16x8 af[8], bfr[4];
#pragma unroll
        for (int n = 0; n < 4; ++n) bfr[n] = *(const bf16x8*)(s + 16384 + (wc * 64 + n * 16 + fr) * 64 + fsw);
#pragma unroll
        for (int m = 0; m < 8; ++m) af[m] = *(const bf16x8*)(s + (wr * 128 + m * 16 + fr) * 64 + fsw);
#pragma unroll
        for (int m = 0; m < 8; ++m)
#pragma unroll
            for (int n = 0; n < 4; ++n) acc[m][n] = __builtin_amdgcn_mfma_f32_16x16x32_bf16(bfr[n], af[m], acc[m][n], 0, 0, 0);
    }
    asm volatile("s_waitcnt lgkmcnt(0)" ::: "memory");
    __builtin_amdgcn_s_barrier();
    asm volatile("" ::: "memory");
#if PROBE_INNER
    if (threadIdx.x == 0) { volatile unsigned* w = (volatile unsigned*)(lds + LDS_CTL + 32); if (w[1]) *w = *w + (unsigned)(__builtin_amdgcn_s_memrealtime() - pi_t0); }
#endif
}

__device__ const double k_rope_consts[10] = {1.0, 0.19392274474868576, 0.03760603093086393, 0.007292664737217109, 0.001414213562373095,
                                             0.0002742481756762073, 5.318295896944988e-05, 1.031338537721246e-05, 6.283185307179586, 0.15915494309189535};
struct TJob { const float* W; bf16_t* WT; int K, ldw, n_src0, ncols, dst_row0, nb; size_t sstride, dstride; const float* kscale; };
DEVFI void tj_load(const TJob& j, int it, int per, int nnb, int lane, f32x4 (&v)[8]) {
    const int b = it / per, r = it % per, kb = r / nnb, nb = r % nnb;
    const int nc = (j.ncols - nb * 32) < 32 ? (j.ncols - nb * 32) : 32;
    const float* src = j.W + (size_t)b * j.sstride + (size_t)(kb * 64 + (lane >> 3)) * j.ldw + j.n_src0 + nb * 32 + (lane & 7) * 4;
    const bool ok = (lane & 7) * 4 < nc;
#pragma unroll
    for (int i = 0; i < 8; ++i) v[i] = ok ? *(const f32x4*)(src + (size_t)(8 * i) * j.ldw) : (f32x4){0.f, 0.f, 0.f, 0.f};
}
DEVFI void tj_store(const TJob& j, int it, int per, int nnb, int lane, const f32x4 (&v)[8], float* scr) {
    const int b = it / per, r = it % per, kb = r / nnb, nb = r % nnb;
    const int nc = (j.ncols - nb * 32) < 32 ? (j.ncols - nb * 32) : 32;
    const int k0 = kb * 64;
#pragma unroll
    for (int i = 0; i < 8; ++i) {
        const int row = 8 * i + (lane >> 3);
        const float sc = j.kscale ? j.kscale[k0 + row] : 1.f;
        float* d = scr + row * 33 + (lane & 7) * 4;
        d[0] = v[i][0] * sc; d[1] = v[i][1] * sc; d[2] = v[i][2] * sc; d[3] = v[i][3] * sc;
    }
    asm volatile("s_waitcnt lgkmcnt(0)" ::: "memory");
    const int ch = lane & 7;
    bf16_t* WT = j.WT + (size_t)b * j.dstride;
#pragma unroll
    for (int q = 0; q < 4; ++q) {
        const int n = (lane >> 3) + 8 * q; const float* s = scr + (8 * ch) * 33 + n;
        uint4 o; o.x = pk2(s[0 * 33], s[1 * 33]); o.y = pk2(s[2 * 33], s[3 * 33]); o.z = pk2(s[4 * 33], s[5 * 33]); o.w = pk2(s[6 * 33], s[7 * 33]);
        if (n < nc) *(uint4*)(WT + (size_t)(j.dst_row0 + nb * 32 + n) * j.K + k0 + 8 * ch) = o;
    }
    asm volatile("s_waitcnt lgkmcnt(0)" ::: "memory");
}
DEVFI void run_tjob(const TJob& j, float* scr, int gw, int ngw, int lane) {
    const int nkb = j.K / 64, nnb = (j.ncols + 31) / 32, per = nkb * nnb, total = per * j.nb;
    int it = gw;
    f32x4 cur[8];
    if (it < total) tj_load(j, it, per, nnb, lane, cur);
    while (it < total) {
        const int nx = it + ngw;
        f32x4 nxt[8];
        if (nx < total) tj_load(j, nx, per, nnb, lane, nxt);
        tj_store(j, it, per, nnb, lane, cur, scr);
#pragma unroll
        for (int i = 0; i < 8; ++i) cur[i] = nxt[i];
        it = nx;
    }
}

DEVFI void phase_prep(KP p, unsigned char* lds) {
    const int tid = opaque_tid(), lane = tid & 63, wid = tid >> 6;
    const int gw = blockIdx.x * 8 + wid, ngw = gridDim.x * 8;
    const int gt = blockIdx.x * 512 + tid, ngt = gridDim.x * 512;
    float* scr = (float*)(lds + wid * 8704);
    unsigned char* ws = p->ws;
    for (int l = 0; l < DEPTH; ++l) {
        const float* win = (const float*)p->in[4] + (size_t)l * 1024 * IN_COLS;
        bf16_t* wint = (bf16_t*)(ws + WS_WIN) + (size_t)l * ZN * 1024;
        TJob j;
        j.nb = 1; j.sstride = 0; j.dstride = 0;
        j.kscale = (const float*)p->in[2] + (size_t)l * 1024;
        j.W = win; j.WT = wint; j.K = 1024; j.ldw = IN_COLS;
        j.n_src0 = 0; j.ncols = 1280; j.dst_row0 = 0; run_tjob(j, scr, gw, ngw, lane);
        j.n_src0 = SC_NG; j.ncols = 24; j.dst_row0 = ZC_NG; run_tjob(j, scr, gw, ngw, lane);
        j.n_src0 = SC_U; j.ncols = 256; j.dst_row0 = ZC_U; run_tjob(j, scr, gw, ngw, lane);
        j.n_src0 = SC_GA; j.ncols = 1024; j.dst_row0 = ZC_GA; run_tjob(j, scr, gw, ngw, lane);
        j.n_src0 = SC_GS; j.ncols = 1024; j.dst_row0 = ZC_GS; run_tjob(j, scr, gw, ngw, lane);
        { uint4* z = (uint4*)(wint + (size_t)IN_COLS * 1024); const int n16 = (ZN - IN_COLS) * 1024 * 2 / 16;
          const unsigned uz = __float_as_uint(opaque_zero());
          for (int i = gt; i < n16; i += ngt) z[i] = make_uint4(uz, uz, uz, uz); }
        j.kscale = nullptr;
        j.K = 2048; j.ldw = 128; j.n_src0 = 0; j.ncols = 128; j.dst_row0 = 0;
        j.W = (const float*)p->in[8] + (size_t)l * 2048 * 128; j.WT = (bf16_t*)(ws + WS_CW1) + (size_t)(l * 2 + 0) * 128 * 2048; run_tjob(j, scr, gw, ngw, lane);
        j.W = (const float*)p->in[11] + (size_t)l * 2048 * 128; j.WT = (bf16_t*)(ws + WS_CW1) + (size_t)(l * 2 + 1) * 128 * 2048; run_tjob(j, scr, gw, ngw, lane);
        j.K = 256; j.ldw = 512; j.ncols = 512; j.W = (const float*)p->in[21] + (size_t)l * 256 * 512; j.WT = (bf16_t*)(ws + WS_GLU) + (size_t)l * 512 * 256; run_tjob(j, scr, gw, ngw, lane);
        j.K = 512; j.ldw = 1024; j.ncols = 1024; j.W = (const float*)p->in[22] + (size_t)l * 512 * 1024; j.WT = (bf16_t*)(ws + WS_PA) + (size_t)l * 1024 * 512; run_tjob(j, scr, gw, ngw, lane);
        j.K = 256; j.ldw = 1024; j.ncols = 1024; j.W = (const float*)p->in[23] + (size_t)l * 256 * 1024; j.WT = (bf16_t*)(ws + WS_PS) + (size_t)l * 1024 * 256; run_tjob(j, scr, gw, ngw, lane);
        j.K = 1024; j.ldw = 1024; j.ncols = 1024; j.W = (const float*)p->in[24] + (size_t)l * 1024 * 1024; j.WT = (bf16_t*)(ws + WS_WO) + (size_t)l * 1024 * 1024; run_tjob(j, scr, gw, ngw, lane);
        j.nb = 32;
        j.kscale = (const float*)p->in[3] + (size_t)l * 1024;
        j.K = 1024; j.ldw = 512; j.ncols = 512; j.sstride = (size_t)1024 * 512; j.dstride = (size_t)512 * 1024;
        j.W = (const float*)p->in[29] + (size_t)l * 32 * 1024 * 512; j.WT = (bf16_t*)(ws + WS_EG) + (size_t)l * 32 * 512 * 1024; run_tjob(j, scr, gw, ngw, lane);
        j.W = (const float*)p->in[30] + (size_t)l * 32 * 1024 * 512; j.WT = (bf16_t*)(ws + WS_EU) + (size_t)l * 32 * 512 * 1024; run_tjob(j, scr, gw, ngw, lane);
        j.kscale = nullptr;
        j.K = 512; j.ldw = 1024; j.ncols = 1024; j.sstride = (size_t)512 * 1024; j.dstride = (size_t)1024 * 512;
        j.W = (const float*)p->in[31] + (size_t)l * 32 * 512 * 1024; j.WT = (bf16_t*)(ws + WS_ED) + (size_t)l * 32 * 1024 * 512; run_tjob(j, scr, gw, ngw, lane);
    }
    {
        const int* pos = (const int*)p->in[1]; float* rope = (float*)(ws + WS_ROPE);
        for (int i = gt; i < NTOK * 8; i += ngt) {
            const int n = i >> 3, f = i & 7;
            const double ang = (double)pos[n] * k_rope_consts[f];
            const double r = ang - k_rope_consts[8] * __builtin_rint(ang * k_rope_consts[9]);
            const float rf = (float)r;
            rope[n * 16 + f] = cosf(rf); rope[n * 16 + 8 + f] = sinf(rf);
        }
    }
    {
        float* LB = (float*)(ws + WS_S5LB); float* BB = (float*)(ws + WS_S5BB);
        const float* are = (const float*)p->in[13]; const float* aim = (const float*)p->in[14]; const float* ldt = (const float*)p->in[15];
        const float* bre = (const float*)p->in[16]; const float* bim = (const float*)p->in[17];
        for (int i = gt; i < DEPTH * 16 * 64; i += ngt) {
            const int lg = i >> 6;
            const float lre = fminf(are[i], -1e-4f), lim = aim[i];
            const float dt = expf(ldt[lg]);
            const float a = lre * dt, bq = lim * dt;
            const float em = expm1f(a), cb = cosf(bq), sb = sinf(bq), sh = sinf(0.5f * bq);
            const float lbr = (em + 1.f) * cb, lbi = (em + 1.f) * sb, lm1 = em * cb - 2.f * sh * sh;
            const float den = lre * lre + lim * lim;
            const float fr_ = (lm1 * lre + lbi * lim) / den, fi_ = (lbi * lre - lm1 * lim) / den;
            LB[i * 2] = lbr; LB[i * 2 + 1] = lbi;
            for (int c = 0; c < 16; ++c) {
                const float br = bre[(size_t)i * 16 + c], bi = bim[(size_t)i * 16 + c];
                BB[((size_t)i * 16 + c) * 2] = fr_ * br - fi_ * bi;
                BB[((size_t)i * 16 + c) * 2 + 1] = fr_ * bi + fi_ * br;
            }
        }
    }
    {
        float* POW = (float*)(ws + WS_POW);
        const float* are = (const float*)p->in[13]; const float* aim = (const float*)p->in[14]; const float* ldt = (const float*)p->in[15];
        for (int i = gt; i < DEPTH * 16 * 64 * 65; i += ngt) {
            const int n = i % 65, lgp = i / 65, lg = lgp >> 6;
            const float lre = fminf(are[lgp], -1e-4f), lim = aim[lgp];
            const float dt = expf(ldt[lg]);
            const float mag = expf((float)n * (lre * dt));
            const double ang = (double)n * ((double)lim * (double)dt);
            const float rf = (float)(ang - k_rope_consts[8] * __builtin_rint(ang * k_rope_consts[9]));
            POW[(size_t)i * 2] = mag * cosf(rf); POW[(size_t)i * 2 + 1] = mag * sinf(rf);
        }
    }
    for (int l = 0; l < DEPTH; ++l) {
        TJob j; j.kscale = nullptr; j.nb = 1; j.sstride = 0; j.dstride = 0; j.K = 128; j.ldw = 64; j.n_src0 = 0; j.ncols = 64; j.dst_row0 = 0;
        j.W = (const float*)p->in[9] + (size_t)l * 128 * 64; j.WT = (bf16_t*)(ws + WS_CW2T) + (size_t)(l * 2 + 0) * 64 * 128; run_tjob(j, scr, gw, ngw, lane);
        j.W = (const float*)p->in[12] + (size_t)l * 128 * 64; j.WT = (bf16_t*)(ws + WS_CW2T) + (size_t)(l * 2 + 1) * 64 * 128; run_tjob(j, scr, gw, ngw, lane);
    }
    {
        float* WRT = (float*)(ws + WS_WRT);
        for (int i = gt; i < DEPTH * 48 * 1024; i += ngt) {
            const int k = i & 1023, jn = (i >> 10) % 48, l = (i >> 10) / 48;
            const float gn = ((const float*)p->in[3])[l * 1024 + k];
            float w = 0.f;
            if (jn < 4) w = ((const float*)p->in[25])[((size_t)l * 1024 + k) * 4 + jn];
            else if (jn < 36) w = ((const float*)p->in[27])[((size_t)l * 1024 + k) * 32 + (jn - 4)];
            WRT[i] = gn * w;
        }
    }
    {
        float* CB = (float*)(ws + WS_CB1);
        for (int o = gw; o < DEPTH * 2 * 128; o += ngw) {
            const int l = o >> 8, kv = (o >> 7) & 1, jn = o & 127;
            const float* pe = (const float*)p->in[kv ? 10 : 7] + (size_t)l * 2048;
            const float* w1 = (const float*)p->in[kv ? 11 : 8] + (size_t)l * 2048 * 128;
            float s = 0.f;
            for (int k = lane; k < 2048; k += 64) s += pe[k] * w1[(size_t)k * 128 + jn];
            s = wave_sum(s);
            if (lane == 0) CB[o] = s;
        }
    }
}


DEVFI void phase_prep1(KP p) {
    const int tid = opaque_tid();
    const int gt = blockIdx.x * 512 + tid, ngt = gridDim.x * 512;
    unsigned char* ws = p->ws;
    const float* POW = (const float*)(ws + WS_POW); const float* BB = (const float*)(ws + WS_S5BB);
    const float* cre = (const float*)p->in[18]; const float* cim = (const float*)p->in[19];
    bf16_t* KT = (bf16_t*)(ws + WS_KTAB); bf16_t* MS = (bf16_t*)(ws + WS_MSTATE); bf16_t* MC = (bf16_t*)(ws + WS_MCARRY);
    for (int i = gt; i < DEPTH * 16 * 66 * 256; i += ngt) {
        const int cc = i & 15, c = (i >> 4) & 15, row = (i >> 8) % 66, lg = (i >> 8) / 66;
        float acc = 0.f;
        if (row >= 1 && row <= 64) {
            const int tau = row - 1;
            const float* pw = POW + ((size_t)(lg * 64) * 65 + tau) * 2;
            const float* bb = BB + ((size_t)(lg * 64) * 16 + cc) * 2;
            const float* cr_ = cre + ((size_t)lg * 16 + c) * 64; const float* ci_ = cim + ((size_t)lg * 16 + c) * 64;
            for (int p8 = 0; p8 < 64; p8 += 8) {
                float wr[8], wi[8], br[8], bi[8], cr[8], ci[8];
#pragma unroll
                for (int e = 0; e < 8; ++e) {
                    const int pq = p8 + e;
                    wr[e] = pw[(size_t)pq * 130]; wi[e] = pw[(size_t)pq * 130 + 1];
                    br[e] = bb[(size_t)pq * 32]; bi[e] = bb[(size_t)pq * 32 + 1];
                    cr[e] = cr_[pq]; ci[e] = ci_[pq];
                }
#pragma unroll
                for (int e = 0; e < 8; ++e) { const float tr = wr[e] * br[e] - wi[e] * bi[e], ti = wr[e] * bi[e] + wi[e] * br[e]; acc += cr[e] * tr - ci[e] * ti; }
            }
        }
        KT[i] = (bf16_t)f2bf(acc);
    }
    for (int i = gt; i < DEPTH * 16 * 128 * 128; i += ngt) {
        const int half = i & 1, sidx = (i >> 1) & 63, pp = (i >> 7) & 127, lg = i >> 14;
        const int pq = pp & 63;
        const float wr = POW[((size_t)(lg * 64 + pq) * 65 + (63 - sidx)) * 2], wi = POW[((size_t)(lg * 64 + pq) * 65 + (63 - sidx)) * 2 + 1];
        const f32x4* bp = (const f32x4*)(BB + ((size_t)(lg * 64 + pq) * 16 + half * 8) * 2);
        const f32x4 b0 = bp[0], b1 = bp[1], b2 = bp[2], b3 = bp[3];
        float o[8];
        if (pp < 64) { o[0] = wr * b0[0] - wi * b0[1]; o[1] = wr * b0[2] - wi * b0[3]; o[2] = wr * b1[0] - wi * b1[1]; o[3] = wr * b1[2] - wi * b1[3];
                       o[4] = wr * b2[0] - wi * b2[1]; o[5] = wr * b2[2] - wi * b2[3]; o[6] = wr * b3[0] - wi * b3[1]; o[7] = wr * b3[2] - wi * b3[3]; }
        else         { o[0] = wr * b0[1] + wi * b0[0]; o[1] = wr * b0[3] + wi * b0[2]; o[2] = wr * b1[1] + wi * b1[0]; o[3] = wr * b1[3] + wi * b1[2];
                       o[4] = wr * b2[1] + wi * b2[0]; o[5] = wr * b2[3] + wi * b2[2]; o[6] = wr * b3[1] + wi * b3[0]; o[7] = wr * b3[3] + wi * b3[2]; }
        uint4 w; w.x = pk2(o[0], o[1]); w.y = pk2(o[2], o[3]); w.z = pk2(o[4], o[5]); w.w = pk2(o[6], o[7]);
        *(uint4*)(MS + ((size_t)(lg * 128 + pp) * 1024 + sidx * 16 + half * 8)) = w;
    }
    for (int i = gt; i < DEPTH * 16 * 1024 * 16; i += ngt) {
        const int p8 = i & 15, n = (i >> 4) & 1023, lg = i >> 14;
        const int t = n >> 4, c = n & 15, pq0 = (p8 & 7) * 8;
        const bool isre = p8 < 8;
        const f32x4* crp = (const f32x4*)(cre + ((size_t)lg * 16 + c) * 64 + pq0); const f32x4* cip = (const f32x4*)(cim + ((size_t)lg * 16 + c) * 64 + pq0);
        const f32x4 cr0 = crp[0], cr1 = crp[1], ci0 = cip[0], ci1 = cip[1];
        float o[8];
#pragma unroll
        for (int e = 0; e < 8; ++e) {
            const float wr = POW[((size_t)(lg * 64 + pq0 + e) * 65 + (t + 1)) * 2], wi = POW[((size_t)(lg * 64 + pq0 + e) * 65 + (t + 1)) * 2 + 1];
            const float cr = e < 4 ? cr0[e & 3] : cr1[e & 3], ci = e < 4 ? ci0[e & 3] : ci1[e & 3];
            o[e] = isre ? cr * wr - ci * wi : -(cr * wi + ci * wr);
        }
        uint4 w; w.x = pk2(o[0], o[1]); w.y = pk2(o[2], o[3]); w.z = pk2(o[4], o[5]); w.w = pk2(o[6], o[7]);
        *(uint4*)(MC + ((size_t)(lg * 1024 + n) * 128 + p8 * 8)) = w;
    }
}

DEVFI int seg_start_lane(const int* cnt, int lane) {
    const int c = (lane < 32) ? cnt[lane] : 0;
    const int pad = (c + 255) & ~255;
    int incl = pad;
#pragma unroll
    for (int o = 1; o < 32; o <<= 1) { const int v = __shfl_up(incl, o); if ((lane & 31) >= o) incl += v; }
    return incl - pad;
}

DEVFI void stage_norm1(KP p, int l, bool final_only) {
    const int tid = opaque_tid(), lane = tid & 63, wid = tid >> 6;
    const int gw = blockIdx.x * 8 + wid, ngw = gridDim.x * 8;
    unsigned char* ws = p->ws;
    const float* xin = (const float*)p->in[0];
    float* xres = p->out;
    bf16_t* XB = (bf16_t*)(ws + WS_H);
    float* RS = (float*)(ws + WS_RSTD);
    const bf16_t* Y = (const bf16_t*)(ws + WS_Y);
    const int* eid = (const int*)(ws + WS_EID); const float* ew = (const float*)(ws + WS_EW); const int* epos = (const int*)(ws + WS_EPOS);
    int segs = 0;
    if (l > 0) segs = seg_start_lane((const int*)(ws + CTL_CNT) + (l - 1) * 32, lane);
    for (int row0 = gw * 2; row0 < NTOK; row0 += ngw * 2) {
        f32x4 v[2][4];
        if (l == 0) {
#pragma unroll
            for (int q = 0; q < 2; ++q)
#pragma unroll
                for (int j = 0; j < 4; ++j) v[q][j] = *(const f32x4*)(xin + (size_t)(row0 + q) * 1024 + lane * 4 + 256 * j);
        } else {
            uint2 ya[2][4], yb[2][4]; float w0[2], w1[2];
#pragma unroll
            for (int q = 0; q < 2; ++q) {
                const int row = row0 + q;
                const int e0 = eid[row * 2], e1 = eid[row * 2 + 1];
                w0[q] = ew[row * 2]; w1[q] = ew[row * 2 + 1];
                const int s0 = __shfl(segs, e0) + epos[row * 2], s1 = __shfl(segs, e1) + epos[row * 2 + 1];
#pragma unroll
                for (int j = 0; j < 4; ++j) {
                    v[q][j] = *(const f32x4*)(xres + (size_t)row * 1024 + lane * 4 + 256 * j);
                    ya[q][j] = *(const uint2*)(Y + (size_t)s0 * 1024 + lane * 4 + 256 * j);
                    yb[q][j] = *(const uint2*)(Y + (size_t)s1 * 1024 + lane * 4 + 256 * j);
                }
            }
#pragma unroll
            for (int q = 0; q < 2; ++q)
#pragma unroll
                for (int j = 0; j < 4; ++j) {
                    const uint2 a = ya[q][j], bq = yb[q][j];
                    v[q][j][0] += w0[q] * __uint_as_float(a.x << 16) + w1[q] * __uint_as_float(bq.x << 16);
                    v[q][j][1] += w0[q] * __uint_as_float(a.x & 0xffff0000u) + w1[q] * __uint_as_float(bq.x & 0xffff0000u);
                    v[q][j][2] += w0[q] * __uint_as_float(a.y << 16) + w1[q] * __uint_as_float(bq.y << 16);
                    v[q][j][3] += w0[q] * __uint_as_float(a.y & 0xffff0000u) + w1[q] * __uint_as_float(bq.y & 0xffff0000u);
                }
        }
#pragma unroll
        for (int q = 0; q < 2; ++q) {
            const int row = row0 + q;
#pragma unroll
            for (int j = 0; j < 4; ++j) *(f32x4*)(xres + (size_t)row * 1024 + lane * 4 + 256 * j) = v[q][j];
            if (final_only) continue;
            float ss = 0.f;
#pragma unroll
            for (int j = 0; j < 4; ++j) ss += v[q][j][0] * v[q][j][0] + v[q][j][1] * v[q][j][1] + v[q][j][2] * v[q][j][2] + v[q][j][3] * v[q][j][3];
            ss = wave_sum(ss);
            if (lane == 0) RS[row] = rsqrtf(ss * (1.f / 1024.f) + RMS_EPS);
#pragma unroll
            for (int j = 0; j < 4; ++j) {
                uint2 o; o.x = pk2(v[q][j][0], v[q][j][1]); o.y = pk2(v[q][j][2], v[q][j][3]);
                *(uint2*)(XB + (size_t)row * 1024 + lane * 4 + 256 * j) = o;
            }
        }
    }
}

DEVFI void stage_inproj(KP p, int l, unsigned char* lds) {
    unsigned char* ws = p->ws;
    const bf16_t* H = (const bf16_t*)(ws + WS_H);
    const bf16_t* W = (const bf16_t*)(ws + WS_WIN) + (size_t)l * ZN * 1024;
    bf16_t* Z = (bf16_t*)(ws + WS_Z);
    const float* RS = (const float*)(ws + WS_RSTD);
    constexpr int NMT = NTOK / 256, NNT = ZN / 256;
    for (int u = blockIdx.x; u < NMT * NNT; u += gridDim.x) {
        const int tid = opaque_tid();
        const int mt = u % NMT, nt = u / NMT;
        const bf16_t* a0 = H + (size_t)(mt * 256 + (tid >> 2)) * 1024 + SWZ_CHUNK(tid);
        const bf16_t* b0 = W + (size_t)(nt * 256 + (tid >> 2)) * 1024 + SWZ_CHUNK(tid);
        f32x4 acc[8][4];
        gemm_tile8(lds, a0, a0 + (size_t)128 * 1024, b0, b0 + (size_t)128 * 1024, 32, acc);
        const int tid2 = opaque_tid(), lane2 = tid2 & 63, wid2 = tid2 >> 6, wr = wid2 >> 2, wc = wid2 & 3, fr = lane2 & 15, fq = lane2 >> 4;
#pragma unroll
        for (int m = 0; m < 8; ++m) {
            const int row = mt * 256 + wr * 128 + m * 16 + fr;
            const float rs = RS[row];
#pragma unroll
            for (int n = 0; n < 4; ++n) {
                const int col = nt * 256 + wc * 64 + n * 16 + fq * 4;
                uint2 o; o.x = pk2(acc[m][n][0] * rs, acc[m][n][1] * rs); o.y = pk2(acc[m][n][2] * rs, acc[m][n][3] * rs);
                *(uint2*)(Z + (size_t)row * ZN + col) = o;
            }
        }
    }
}

DEVFI void s5_unit(KP p, int l, int b, int g, unsigned char* lds, const int tid) {
    const int lane = tid & 63, wid = tid >> 6, fr = lane & 15, fq = lane >> 4;
    unsigned char* ws = p->ws;
    const bf16_t* Z = (const bf16_t*)(ws + WS_Z);
    const int lg = l * 16 + g;
    const bf16_t* KT = (const bf16_t*)(ws + WS_KTAB) + (size_t)lg * 66 * 256;
    const bf16_t* MS = (const bf16_t*)(ws + WS_MSTATE) + (size_t)lg * 128 * 1024;
    const bf16_t* MC = (const bf16_t*)(ws + WS_MCARRY) + (size_t)lg * 1024 * 128;
    unsigned char* ul = lds;
    unsigned char* kl = lds + 65536;
    float* sl = (float*)(lds + 100352);
    unsigned char* xl = lds + 116736;
    {
        const int chunk = (tid >> 2) & 31, slot = tid & 3;
#pragma unroll
        for (int i = 0; i < 8; ++i) {
            const int pan = i * 4 + (tid >> 7), sidx = 2 * pan + (slot >> 1);
            glds16(Z + (size_t)(b * SEQ + chunk * 64 + sidx) * ZN + ZC_U + g * 16 + (slot & 1) * 8, ul + i * 8192 + tid * 16);
        }
#pragma unroll
        for (int i = 0; i < 4; ++i) glds16(KT + (size_t)(i * 512 + tid) * 8, kl + i * 8192 + tid * 16);
        if (wid == 0) glds16(KT + (size_t)(2048 + tid) * 8, kl + 32768 + tid * 16);
    }
    asm volatile("s_waitcnt vmcnt(0)" ::: "memory");
    __syncthreads();
    {
        f32x4 acc[2] = {{0.f, 0.f, 0.f, 0.f}, {0.f, 0.f, 0.f, 0.f}};
        const bf16_t* bp = MS + (size_t)(wid * 16 + fr) * 1024 + fq * 8;
#pragma unroll 4
        for (int kk = 0; kk < 32; ++kk) {
            const bf16x8 bfv = *(const bf16x8*)(bp + kk * 32);
#pragma unroll
            for (int mt = 0; mt < 2; ++mt) {
                const bf16x8 af = *(const bf16x8*)(ul + kk * 2048 + (mt * 16 + fr) * 64 + fq * 16);
                acc[mt] = __builtin_amdgcn_mfma_f32_16x16x32_bf16(bfv, af, acc[mt], 0, 0, 0);
            }
        }
#pragma unroll
        for (int mt = 0; mt < 2; ++mt) *(f32x4*)(sl + (mt * 16 + fr) * 128 + wid * 16 + fq * 4) = acc[mt];
    }
    __syncthreads();
    if (wid == 0) {
        const float* POW = (const float*)(ws + WS_POW);
        const float tr = POW[((size_t)(lg * 64 + lane) * 65 + 64) * 2], ti = POW[((size_t)(lg * 64 + lane) * 65 + 64) * 2 + 1];
        float xr = 0.f, xi = 0.f;
        for (int k = 0; k < 32; ++k) {
            *(bf16_t*)(xl + (lane >> 5) * 2048 + k * 64 + (lane & 31) * 2) = (bf16_t)f2bf(xr);
            *(bf16_t*)(xl + (2 + (lane >> 5)) * 2048 + k * 64 + (lane & 31) * 2) = (bf16_t)f2bf(xi);
            const float sr = sl[k * 128 + lane], si = sl[k * 128 + 64 + lane];
            const float nr = tr * xr - ti * xi + sr, ni = tr * xi + ti * xr + si;
            xr = nr; xi = ni;
        }
    }
    __syncthreads();
    {
        const float* dsk = (const float*)p->in[20] + l * 256 + g * 16;
        const f32x4 dv = *(const f32x4*)(dsk + fq * 4);
        bf16_t* YB = (bf16_t*)(ws + WS_YB);
#pragma unroll 1
        for (int i = 0; i < 8; ++i) {
            const int t = wid + 8 * i;
            f32x4 acc[2] = {{0.f, 0.f, 0.f, 0.f}, {0.f, 0.f, 0.f, 0.f}};
            const int nk = (t >> 1) + 1;
            for (int kk = 0; kk < nk; ++kk) {
                const int srow = t - (2 * kk + (fq >> 1)) + 1;
                const bf16x8 bfv = *(const bf16x8*)(kl + srow * 512 + fr * 32 + (fq & 1) * 16);
#pragma unroll
                for (int mt = 0; mt < 2; ++mt) {
                    const bf16x8 af = *(const bf16x8*)(ul + kk * 2048 + (mt * 16 + fr) * 64 + fq * 16);
                    acc[mt] = __builtin_amdgcn_mfma_f32_16x16x32_bf16(bfv, af, acc[mt], 0, 0, 0);
                }
            }
            const bf16_t* cp = MC + (size_t)(t * 16 + fr) * 128 + fq * 8;
#pragma unroll
            for (int kk = 0; kk < 4; ++kk) {
                const bf16x8 bfv = *(const bf16x8*)(cp + kk * 32);
#pragma unroll
                for (int mt = 0; mt < 2; ++mt) {
                    const bf16x8 af = *(const bf16x8*)(xl + kk * 2048 + (mt * 16 + fr) * 64 + fq * 16);
                    acc[mt] = __builtin_amdgcn_mfma_f32_16x16x32_bf16(bfv, af, acc[mt], 0, 0, 0);
                }
            }
#pragma unroll
            for (int mt = 0; mt < 2; ++mt) {
                const size_t n = (size_t)b * SEQ + (mt * 16 + fr) * 64 + t;
                const uint2 uu = *(const uint2*)(Z + n * ZN + ZC_U + g * 16 + fq * 4);
                const float u0 = __uint_as_float(uu.x << 16), u1 = __uint_as_float(uu.x & 0xffff0000u), u2 = __uint_as_float(uu.y << 16), u3 = __uint_as_float(uu.y & 0xffff0000u);
                uint2 w;
                w.x = pk2(gelu_tanh(acc[mt][0] + dv[0] * u0), gelu_tanh(acc[mt][1] + dv[1] * u1));
                w.y = pk2(gelu_tanh(acc[mt][2] + dv[2] * u2), gelu_tanh(acc[mt][3] + dv[3] * u3));
                *(uint2*)(YB + n * 256 + g * 16 + fq * 4) = w;
            }
        }
    }
    __syncthreads();
}

DEVFI void cmp_unit(KP p, int l, int u, unsigned char* lds, const int tid) {
    const int lane = tid & 63, wid = tid >> 6, wr = wid >> 1, wc = wid & 1, fr = lane & 15, fq = lane >> 4;
    unsigned char* ws = p->ws;
    const bf16_t* Z = (const bf16_t*)(ws + WS_Z);
    const bf16_t* W1 = (const bf16_t*)(ws + WS_CW1) + (size_t)l * 2 * 128 * 2048;
    const float* CB = (const float*)(ws + WS_CB1) + l * 256;
    constexpr int MR = BATCH * 2 * NCMP;
    const int kv = u >> 3, mt = u & 7;
    auto rowptr = [&](int r) -> const bf16_t* {
        if (r >= MR) r = MR - 1;
        const int bh = r / NCMP, c = r % NCMP, b = bh >> 1, hk = bh & 1;
        return Z + (size_t)(b * SEQ + 16 * c) * ZN + (kv ? ZC_VC : ZC_KC) + hk * 64;
    };
    const bf16_t* a0 = rowptr(mt * 256 + (tid >> 2)) + SWZ_CHUNK(tid);
    const bf16_t* a1 = rowptr(mt * 256 + 128 + (tid >> 2)) + SWZ_CHUNK(tid);
    const bf16_t* b0 = W1 + (size_t)kv * 128 * 2048 + (size_t)(tid >> 2) * 2048 + SWZ_CHUNK(tid);
    f32x4 acc[1][4][4];
    gemm_tile<1>(lds, a0, a1, ZN, b0, nullptr, 32, acc);
#pragma unroll
    for (int m = 0; m < 4; ++m)
#pragma unroll
        for (int n = 0; n < 4; ++n) {
            const int row = wr * 64 + m * 16 + fr, col = wc * 64 + n * 16 + fq * 4;
            float o[4];
#pragma unroll
            for (int r = 0; r < 4; ++r) o[r] = gelu_tanh(acc[0][m][n][r] + CB[kv * 128 + col + r]);
            uint2 w; w.x = pk2(o[0], o[1]); w.y = pk2(o[2], o[3]);
            *(uint2*)(lds + (col >> 5) * 16384 + row * 64 + (col & 31) * 2) = w;
        }
    __syncthreads();
    const bf16_t* W2 = (const bf16_t*)(ws + WS_CW2T) + (size_t)(l * 2 + kv) * 64 * 128;
    f32x4 o2[2][4];
#pragma unroll
    for (int m = 0; m < 2; ++m)
#pragma unroll
        for (int n = 0; n < 4; ++n) o2[m][n] = (f32x4){0.f, 0.f, 0.f, 0.f};
#pragma unroll
    for (int kk = 0; kk < 4; ++kk) {
        bf16x8 af[2], bfv[4];
#pragma unroll
        for (int m = 0; m < 2; ++m) af[m] = *(const bf16x8*)(lds + kk * 16384 + (wid * 32 + m * 16 + fr) * 64 + fq * 16);
#pragma unroll
        for (int n = 0; n < 4; ++n) bfv[n] = *(const bf16x8*)(W2 + (size_t)(n * 16 + fr) * 128 + kk * 32 + fq * 8);
#pragma unroll
        for (int m = 0; m < 2; ++m)
#pragma unroll
            for (int n = 0; n < 4; ++n) o2[m][n] = __builtin_amdgcn_mfma_f32_16x16x32_bf16(bfv[n], af[m], o2[m][n], 0, 0, 0);
    }
    const float* rope = (const float*)(ws + WS_ROPE);
    const float* kg = (const float*)p->in[6] + l * 64;
#pragma unroll
    for (int m = 0; m < 2; ++m) {
        const int row = mt * 256 + wid * 32 + m * 16 + fr;
        const int rr = row < MR ? row : MR - 1;
        const int bh = rr / NCMP, c = rr % NCMP, b = bh >> 1;
        if (kv == 0) {
            float ss = 0.f;
#pragma unroll
            for (int n = 0; n < 4; ++n) ss += o2[m][n][0] * o2[m][n][0] + o2[m][n][1] * o2[m][n][1] + o2[m][n][2] * o2[m][n][2] + o2[m][n][3] * o2[m][n][3];
            ss += __shfl_xor(ss, 16); ss += __shfl_xor(ss, 32);
            const float rstd = rsqrtf(ss * (1.f / 64.f) + RMS_EPS);
#pragma unroll
            for (int n = 0; n < 4; ++n) { const f32x4 gv = *(const f32x4*)(kg + n * 16 + fq * 4); o2[m][n] = o2[m][n] * rstd * gv; }
            const int tokn = b * SEQ + 16 * c + 31;
            const f32x4 cs = *(const f32x4*)(rope + (size_t)tokn * 16 + (fq & 1) * 4), sn = *(const f32x4*)(rope + (size_t)tokn * 16 + 8 + (fq & 1) * 4);
            f32x4 oth;
#pragma unroll
            for (int r = 0; r < 4; ++r) oth[r] = __shfl_xor(o2[m][0][r], 32);
            o2[m][0] = fq < 2 ? o2[m][0] * cs - oth * sn : o2[m][0] * cs + oth * sn;
        }
        if (row < MR) {
            bf16_t* dst = (bf16_t*)(ws + (kv ? WS_VCB : WS_KCB)) + ((size_t)bh * 128 + c) * 64 + fq * 4;
#pragma unroll
            for (int n = 0; n < 4; ++n) {
                uint2 w; w.x = pk2(o2[m][n][0], o2[m][n][1]); w.y = pk2(o2[m][n][2], o2[m][n][3]);
                *(uint2*)(dst + n * 16) = w;
                if (c == 0) *(uint2*)(dst + 127 * 64 + n * 16) = make_uint2(0u, 0u);
            }
        }
    }
    __syncthreads();
}

DEVFI void stage_posta(KP p, int l, unsigned char* lds) {
    const int tid = opaque_tid();
    const int gt = blockIdx.x * 512 + tid, ngt = gridDim.x * 512;
    unsigned char* ws = p->ws;
    for (int u = blockIdx.x; u < BATCH * 16 + 16; u += gridDim.x) {
        if (u < BATCH * 16) s5_unit(p, l, u >> 4, u & 15, lds, tid);
        else cmp_unit(p, l, u - BATCH * 16, lds, tid);
    }
    {
        bf16_t* Z = (bf16_t*)(ws + WS_Z);
        const float* rope = (const float*)(ws + WS_ROPE);
        const float* qg = (const float*)p->in[5] + l * 64; const float* kg = (const float*)p->in[6] + l * 64;
        for (int i = gt; i < NTOK * 12; i += ngt) {
            const int n = i / 12, hs = i % 12;
            const int col = hs < 8 ? ZC_Q + hs * 64 : (hs < 10 ? ZC_KS + (hs - 8) * 64 : ZC_KW + (hs - 10) * 64);
            const float* gn = hs < 8 ? qg : kg;
            bf16_t* zp = Z + (size_t)n * ZN + col;
            float v[64];
#pragma unroll
            for (int j = 0; j < 8; ++j) unpack8(*(const uint4*)(zp + j * 8), v + j * 8);
            float ss = 0.f;
#pragma unroll
            for (int j = 0; j < 64; ++j) ss += v[j] * v[j];
            const float rstd = rsqrtf(ss * (1.f / 64.f) + RMS_EPS);
#pragma unroll
            for (int j = 0; j < 64; ++j) v[j] = v[j] * rstd * gn[j];
#pragma unroll
            for (int f = 0; f < 8; ++f) {
                const float c = rope[n * 16 + f], sn = rope[n * 16 + 8 + f];
                const float x1 = v[f], x2 = v[8 + f];
                v[f] = x1 * c - x2 * sn; v[8 + f] = x2 * c + x1 * sn;
            }
#pragma unroll
            for (int j = 0; j < 8; ++j) {
                uint4 o; o.x = pk2(v[j * 8], v[j * 8 + 1]); o.y = pk2(v[j * 8 + 2], v[j * 8 + 3]); o.z = pk2(v[j * 8 + 4], v[j * 8 + 5]); o.w = pk2(v[j * 8 + 6], v[j * 8 + 7]);
                *(uint4*)(zp + j * 8) = o;
            }
        }
    }
}

DEVFI bf16x8 pack8(const f32x16& v, const int o) {
    const unsigned a = pk2(v[o], v[o + 1]), b = pk2(v[o + 2], v[o + 3]), c = pk2(v[o + 4], v[o + 5]), d = pk2(v[o + 6], v[o + 7]);
    typedef unsigned u32x4 __attribute__((ext_vector_type(4)));
    const u32x4 w = {a, b, c, d};
    return __builtin_bit_cast(bf16x8, w);
}
DEVFI bf16x8 tr_read2(const unsigned char* p) {
    LAS s16x4* q = (LAS s16x4*)(LAS unsigned char*)p;
    const s16x4 a = __builtin_amdgcn_ds_read_tr16_b64_v4i16(q);
    const s16x4 b = __builtin_amdgcn_ds_read_tr16_b64_v4i16(q + 64);
    return (bf16x8){a[0], a[1], a[2], a[3], b[0], b[1], b[2], b[3]};
}
#define KK(reg) (((reg) & 3) + 8 * ((reg) >> 2))
DEVFI void stage_attn(KP p, int l, unsigned char* lds) {
    const int tid = opaque_tid(), lane = tid & 63, wid = tid >> 6, r = lane & 31, h = lane >> 5;
    unsigned char* ws = p->ws;
    const bf16_t* Z = (const bf16_t*)(ws + WS_Z);
    const bf16_t* KCb = (const bf16_t*)(ws + WS_KCB); const bf16_t* VCb = (const bf16_t*)(ws + WS_VCB);
    bf16_t* OA = (bf16_t*)(ws + WS_OA);
    constexpr float SC = 0.125f * 1.4426950408889634f;
    unsigned char* ring = lds; unsigned char* kcl = lds + 32768; unsigned char* vcl = lds + 49152;
    const int xsw = (r >> 2) & 3;
    const int ksl0 = ((0 + h) ^ xsw) * 16, ksl1 = ((2 + h) ^ xsw) * 16;
    const int vlo = (4 * h + ((r & 15) >> 2)) * 64 + ((r >> 4) * 16 + 4 * (r & 3)) * 2;
    const float fz = opaque_zero();
#define ZERO16_LIT ((f32x16){0.f, 0.f, 0.f, 0.f, 0.f, 0.f, 0.f, 0.f, 0.f, 0.f, 0.f, 0.f, 0.f, 0.f, 0.f, 0.f})
#define ZERO16_FZ ((f32x16){fz, fz, fz, fz, fz, fz, fz, fz, fz, fz, fz, fz, fz, fz, fz, fz})
    const int s_pan = tid >> 8, s_key = (tid >> 2) & 63, s_cs = tid & 3, s_kc = s_cs ^ ((s_key >> 2) & 3);
    const int c_key = tid >> 2, c_kc = s_cs ^ ((c_key >> 2) & 3);
    for (int pair = blockIdx.x; pair < 256; pair += gridDim.x) {
        const int bh = pair >> 4, ap = pair & 15, b = bh >> 1, hk = bh & 1;
#pragma unroll 1
        for (int ui = 0; ui < 2; ++ui) {
            const int a = ui == 0 ? 31 - ap : ap;
            const int t0 = 64 * a;
            const int tok = t0 + 8 * wid + (r >> 2), g = r & 3, hq = hk * 4 + g;
            const bf16_t* zrow = Z + (size_t)(b * SEQ + tok) * ZN;
            const int nslc = a + 1, jw0 = a > 8 ? a - 8 : 0, nsteps = nslc + (a - jw0 + 1);
            auto stage_kv = [&](int st, int buf) {
                const bool slc = st < nslc; const int j = slc ? st : jw0 + (st - nslc);
                const bf16_t* src = Z + (size_t)(b * SEQ + 64 * j + s_key) * ZN + hk * 64 + s_pan * 32;
                glds16(src + (slc ? ZC_KS : ZC_KW) + s_kc * 8, ring + buf * 16384 + tid * 16);
                glds16(src + (slc ? ZC_VS : ZC_VW) + s_cs * 8, ring + buf * 16384 + 8192 + tid * 16);
            };
#pragma unroll
            for (int part = 0; part < 2; ++part) {
                glds16(KCb + ((size_t)bh * 128 + c_key) * 64 + part * 32 + c_kc * 8, kcl + part * 8192 + tid * 16);
                glds16(VCb + ((size_t)bh * 128 + c_key) * 64 + part * 32 + s_cs * 8, vcl + part * 8192 + tid * 16);
            }
            stage_kv(0, 0);
            bf16x8 Qf[4];
#pragma unroll
            for (int ks = 0; ks < 4; ++ks) Qf[ks] = *(const bf16x8*)(zrow + ZC_Q + hq * 64 + 16 * ks + 8 * h);
            const float g0 = sigmoidf_(bf2f(zrow[ZC_NG + hq * 3])), g1 = sigmoidf_(bf2f(zrow[ZC_NG + hq * 3 + 1])), g2 = sigmoidf_(bf2f(zrow[ZC_NG + hq * 3 + 2]));
            asm volatile("s_waitcnt vmcnt(0)" ::: "memory");
            __syncthreads();
            f32x16 res[2];
            unsigned selmask;
            {
                f32x16 sc[4];
#pragma unroll
                for (int kt = 0; kt < 4; ++kt) {
                    sc[kt] = ZERO16_LIT;
#pragma unroll
                    for (int ks = 0; ks < 4; ++ks) {
                        const bf16x8 kf = *(const bf16x8*)(kcl + (ks >> 1) * 8192 + (32 * kt + r) * 64 + ((ks & 1) ? ksl1 : ksl0));
                        sc[kt] = __builtin_amdgcn_mfma_f32_32x32x16_bf16(kf, Qf[ks], sc[kt], 0, 0, 0);
                    }
                }
                const int ncv = tok >= 31 ? ((tok - 31) >> 4) + 1 : 0;
                const int cb = ncv - 4 * h;
                float mx = -1e30f;
#pragma unroll
                for (int kt = 0; kt < 4; ++kt)
#pragma unroll
                    for (int reg = 0; reg < 16; ++reg) { const float v = (32 * kt + KK(reg) < cb) ? sc[kt][reg] * SC : -1e30f; sc[kt][reg] = v; mx = fmaxf(mx, v); }
                mx = fmaxf(mx, __shfl_xor(mx, 32));
                float sum = 0.f;
#pragma unroll
                for (int kt = 0; kt < 4; ++kt)
#pragma unroll
                    for (int reg = 0; reg < 16; ++reg) { const float v = sc[kt][reg]; const float pv = v > -1e29f ? __builtin_amdgcn_exp2f(v - mx) : 0.f; sc[kt][reg] = pv; sum += pv; }
                sum += __shfl_xor(sum, 32);
                const float inv = sum > 0.f ? 1.f / sum : 0.f;
#pragma unroll
                for (int kt = 0; kt < 4; ++kt) sc[kt] = sc[kt] * inv;
                f32x16 oc[2]; oc[0] = ZERO16_LIT; oc[1] = ZERO16_LIT;
#pragma unroll
                for (int sp = 0; sp < 8; ++sp) {
                    const bf16x8 pf = pack8(sc[sp >> 1], 8 * (sp & 1));
#pragma unroll
                    for (int dt = 0; dt < 2; ++dt) {
                        const bf16x8 vf = tr_read2(vcl + dt * 8192 + 16 * sp * 64 + vlo);
                        oc[dt] = __builtin_amdgcn_mfma_f32_32x32x16_bf16(vf, pf, oc[dt], 0, 0, 0);
                    }
                }
                res[0] = oc[0] * g0; res[1] = oc[1] * g0;
                float imp[16], lastv[16];
#pragma unroll
                for (int i = 0; i < 16; ++i) { const int kt = i >> 2, q = i & 3; imp[i] = (sc[kt][4 * q] + sc[kt][4 * q + 1]) + (sc[kt][4 * q + 2] + sc[kt][4 * q + 3]); lastv[i] = sc[kt][4 * q + 3]; }
                {
                    float recv[16];
#pragma unroll
                    for (int i = 0; i < 16; ++i) recv[i] = __shfl_xor(lastv[i], 32);
#pragma unroll
                    for (int i = 0; i < 16; ++i) { const float pl = i >= 1 ? recv[i - 1] : 0.f; imp[i] += h ? recv[i] : pl; }
                }
#pragma unroll
                for (int i = 0; i < 16; ++i) { imp[i] += __shfl_xor(imp[i], 1); imp[i] += __shfl_xor(imp[i], 2); }
#pragma unroll
                for (int i = 0; i < 16; ++i) { const int j = 2 * i + h; imp[i] = (j == 0 || j == a || j == a - 1) ? __builtin_inff() : (j > a ? -__builtin_inff() : imp[i]); }
                float* itab = (float*)(lds + 65536) + (8 * wid + (r >> 2)) * 32;
                if (g == 0) {
#pragma unroll
                    for (int i = 0; i < 16; ++i) itab[2 * i + h] = imp[i];
                }
                asm volatile("s_waitcnt lgkmcnt(0)" ::: "memory");
                const int sub = g + 4 * h;
                const f32x4 mine = *(const f32x4*)(itab + 4 * sub);
                int rk0 = 0, rk1 = 0, rk2 = 0, rk3 = 0;
#pragma unroll
                for (int m4 = 0; m4 < 8; ++m4) {
                    const f32x4 vv = *(const f32x4*)(itab + 4 * m4);
#pragma unroll
                    for (int e = 0; e < 4; ++e) {
                        const float vm = vv[e]; const int mi = 4 * m4 + e;
                        rk0 += (int)(vm > mine[0]) | ((int)(vm == mine[0]) & (int)(mi < 4 * sub + 0));
                        rk1 += (int)(vm > mine[1]) | ((int)(vm == mine[1]) & (int)(mi < 4 * sub + 1));
                        rk2 += (int)(vm > mine[2]) | ((int)(vm == mine[2]) & (int)(mi < 4 * sub + 2));
                        rk3 += (int)(vm > mine[3]) | ((int)(vm == mine[3]) & (int)(mi < 4 * sub + 3));
                    }
                }
                unsigned mm = ((rk0 < 16 ? 1u : 0u) | (rk1 < 16 ? 2u : 0u) | (rk2 < 16 ? 4u : 0u) | (rk3 < 16 ? 8u : 0u)) << (4 * sub);
                mm |= (unsigned)__shfl_xor((int)mm, 1); mm |= (unsigned)__shfl_xor((int)mm, 2);
                selmask = mm | (unsigned)__shfl_xor((int)mm, 32);
            }
            f32x16 O[2]; O[0] = ZERO16_FZ; O[1] = ZERO16_FZ;
            float mrun = -1e30f, lpart = fz;
#pragma unroll 1
            for (int st = 0; st < nsteps; ++st) {
                asm volatile("s_waitcnt vmcnt(0)" ::: "memory");
                __syncthreads();
                if (st + 1 < nsteps) stage_kv(st + 1, (st + 1) & 1);
                const bool slc = st < nslc; const int j = slc ? st : jw0 + (st - nslc);
                const unsigned char* kb = ring + (st & 1) * 16384; const unsigned char* vb = kb + 8192;
                f32x16 sc[2];
#pragma unroll
                for (int kt = 0; kt < 2; ++kt) {
                    sc[kt] = ZERO16_LIT;
#pragma unroll
                    for (int ks = 0; ks < 4; ++ks) {
                        const bf16x8 kf = *(const bf16x8*)(kb + (ks >> 1) * 4096 + (32 * kt + r) * 64 + ((ks & 1) ? ksl1 : ksl0));
                        sc[kt] = __builtin_amdgcn_mfma_f32_32x32x16_bf16(kf, Qf[ks], sc[kt], 0, 0, 0);
                    }
                }
                const int base = tok - 64 * j - 4 * h;
                const bool rowok = slc ? ((selmask >> j) & 1u) != 0u : true;
                const unsigned hiu = slc ? 0x7fffffffu : 511u;
                float bm = -1e30f;
#pragma unroll
                for (int kt = 0; kt < 2; ++kt)
#pragma unroll
                    for (int reg = 0; reg < 16; ++reg) {
                        const bool ok = rowok && ((unsigned)(base - (32 * kt + KK(reg))) <= hiu);
                        const float v = ok ? sc[kt][reg] * SC : -1e30f; sc[kt][reg] = v; bm = fmaxf(bm, v);
                    }
                bm = fmaxf(bm, __shfl_xor(bm, 32));
                const float mn = fmaxf(mrun, bm), alpha = __builtin_amdgcn_exp2f(mrun - mn);
                mrun = mn;
                float ps = 0.f;
#pragma unroll
                for (int kt = 0; kt < 2; ++kt)
#pragma unroll
                    for (int reg = 0; reg < 16; ++reg) { const float v = sc[kt][reg]; const float pv = v > -1e29f ? __builtin_amdgcn_exp2f(v - mn) : 0.f; sc[kt][reg] = pv; ps += pv; }
                lpart = lpart * alpha + ps;
                O[0] = O[0] * alpha; O[1] = O[1] * alpha;
#pragma unroll
                for (int sp = 0; sp < 4; ++sp) {
                    const bf16x8 pf = pack8(sc[sp >> 1], 8 * (sp & 1));
#pragma unroll
                    for (int dt = 0; dt < 2; ++dt) {
                        const bf16x8 vf = tr_read2(vb + dt * 4096 + 16 * sp * 64 + vlo);
                        O[dt] = __builtin_amdgcn_mfma_f32_32x32x16_bf16(vf, pf, O[dt], 0, 0, 0);
                    }
                }
                if (st == nslc - 1 || st == nsteps - 1) {
                    const float lt = lpart + __shfl_xor(lpart, 32);
                    const float gsc = (st == nslc - 1 ? g1 : g2) / lt;
                    res[0] = res[0] + O[0] * gsc; res[1] = res[1] + O[1] * gsc;
                    O[0] = ZERO16_FZ; O[1] = ZERO16_FZ; mrun = -1e30f; lpart = fz;
                }
            }
            bf16_t* orow = OA + (size_t)(b * SEQ + tok) * 512 + hq * 64 + 4 * h;
#pragma unroll
            for (int dt = 0; dt < 2; ++dt)
#pragma unroll
                for (int q = 0; q < 4; ++q) {
                    uint2 w; w.x = pk2(res[dt][4 * q], res[dt][4 * q + 1]); w.y = pk2(res[dt][4 * q + 2], res[dt][4 * q + 3]);
                    *(uint2*)(orow + 32 * dt + 8 * q) = w;
                }
            __syncthreads();
        }
    }
    (void)l;
}

DEVFI void stage_glu(KP p, int l, unsigned char* lds) {
    unsigned char* ws = p->ws;
    const bf16_t* YB = (const bf16_t*)(ws + WS_YB);
    const bf16_t* G = (const bf16_t*)(ws + WS_GLU) + (size_t)l * 512 * 256;
    bf16_t* OB = (bf16_t*)(ws + WS_OB);
    for (int u = blockIdx.x; u < 64 * 2; u += gridDim.x) {
        const int tid = opaque_tid();
        const int mt = u >> 1, nt = u & 1;
        const bf16_t* a0 = YB + (size_t)(mt * 256 + (tid >> 2)) * 256 + SWZ_CHUNK(tid);
        const int brow = tid >> 2, sub = brow >> 4;
        const bf16_t* b0 = G + (size_t)((sub & 1) * 256 + nt * 128 + (sub >> 1) * 16 + (brow & 15)) * 256 + SWZ_CHUNK(tid);
        const bf16_t* b1 = G + (size_t)((sub & 1) * 256 + nt * 128 + ((sub + 8) >> 1) * 16 + (brow & 15)) * 256 + SWZ_CHUNK(tid);
        f32x4 acc[8][4];
        gemm_tile8(lds, a0, a0 + (size_t)128 * 256, b0, b1, 8, acc);
        const int tid2 = opaque_tid(), lane2 = tid2 & 63, wid2 = tid2 >> 6, wr = wid2 >> 2, wc = wid2 & 3, fr = lane2 & 15, fq = lane2 >> 4;
#pragma unroll
        for (int m = 0; m < 8; ++m)
#pragma unroll
            for (int n = 0; n < 4; n += 2) {
                const int row = mt * 256 + wr * 128 + m * 16 + fr, col = nt * 128 + (wc * 2 + (n >> 1)) * 16 + fq * 4;
                float o[4];
#pragma unroll
                for (int r = 0; r < 4; ++r) o[r] = acc[m][n][r] * sigmoidf_(acc[m][n + 1][r]);
                uint2 w; w.x = pk2(o[0], o[1]); w.y = pk2(o[2], o[3]);
                *(uint2*)(OB + (size_t)row * 256 + col) = w;
            }
    }
}

DEVFI void stage_merge(KP p, int l, unsigned char* lds) {
    unsigned char* ws = p->ws;
    const bf16_t* OA = (const bf16_t*)(ws + WS_OA); const bf16_t* OB = (const bf16_t*)(ws + WS_OB);
    const bf16_t* PA = (const bf16_t*)(ws + WS_PA) + (size_t)l * 1024 * 512; const bf16_t* PS = (const bf16_t*)(ws + WS_PS) + (size_t)l * 1024 * 256;
    const bf16_t* Z = (const bf16_t*)(ws + WS_Z);
    bf16_t* MRG = (bf16_t*)(ws + WS_MRG);
    for (int u = blockIdx.x; u < 64 * 4; u += gridDim.x) {
        const int mt = u & 63, nt = u >> 6;
#pragma unroll 1
        for (int pass = 0; pass < 2; ++pass) {
            f32x4 acc[8][4];
            {
        const int tid = opaque_tid();
                const int kd = pass == 0 ? 512 : 256;
                const bf16_t* a0 = (pass == 0 ? OA : OB) + (size_t)(mt * 256 + (tid >> 2)) * kd + SWZ_CHUNK(tid);
                const bf16_t* b0 = (pass == 0 ? PA : PS) + (size_t)(nt * 256 + (tid >> 2)) * kd + SWZ_CHUNK(tid);
                gemm_tile8(lds, a0, a0 + (size_t)128 * kd, b0, b0 + (size_t)128 * kd, kd / 32, acc);
            }
        const int tid2 = opaque_tid(), lane2 = tid2 & 63, wid2 = tid2 >> 6, wr = wid2 >> 2, wc = wid2 & 3, fr = lane2 & 15, fq = lane2 >> 4;
            const int gcol = pass == 0 ? ZC_GA : ZC_GS;
#pragma unroll
            for (int m = 0; m < 8; ++m)
#pragma unroll
                for (int n = 0; n < 4; ++n) {
                    const int row = mt * 256 + wr * 128 + m * 16 + fr, col = nt * 256 + wc * 64 + n * 16 + fq * 4;
                    const uint2 gg = *(const uint2*)(Z + (size_t)row * ZN + gcol + col);
                    float o[4];
                    o[0] = sigmoidf_(__uint_as_float(gg.x << 16)) * acc[m][n][0]; o[1] = sigmoidf_(__uint_as_float(gg.x & 0xffff0000u)) * acc[m][n][1];
                    o[2] = sigmoidf_(__uint_as_float(gg.y << 16)) * acc[m][n][2]; o[3] = sigmoidf_(__uint_as_float(gg.y & 0xffff0000u)) * acc[m][n][3];
                    bf16_t* mp = MRG + (size_t)row * 1024 + col;
                    if (pass == 1) {
                        const uint2 pv = *(const uint2*)mp;
                        o[0] += __uint_as_float(pv.x << 16); o[1] += __uint_as_float(pv.x & 0xffff0000u); o[2] += __uint_as_float(pv.y << 16); o[3] += __uint_as_float(pv.y & 0xffff0000u);
                    }
                    uint2 w; w.x = pk2(o[0], o[1]); w.y = pk2(o[2], o[3]);
                    *(uint2*)mp = w;
                }
        }
    }
}

DEVFI void stage_out(KP p, int l, unsigned char* lds) {
    unsigned char* ws = p->ws;
    const bf16_t* MRG = (const bf16_t*)(ws + WS_MRG);
    const bf16_t* WO = (const bf16_t*)(ws + WS_WO) + (size_t)l * 1024 * 1024;
    float* xres = p->out;
    for (int u = blockIdx.x; u < 64 * 4; u += gridDim.x) {
        const int tid = opaque_tid();
        const int mt = u & 63, nt = u >> 6;
        const bf16_t* a0 = MRG + (size_t)(mt * 256 + (tid >> 2)) * 1024 + SWZ_CHUNK(tid);
        const bf16_t* b0 = WO + (size_t)(nt * 256 + (tid >> 2)) * 1024 + SWZ_CHUNK(tid);
        f32x4 acc[8][4];
        gemm_tile8(lds, a0, a0 + (size_t)128 * 1024, b0, b0 + (size_t)128 * 1024, 32, acc);
        const int tid2 = opaque_tid(), lane2 = tid2 & 63, wid2 = tid2 >> 6, wr = wid2 >> 2, wc = wid2 & 3, fr = lane2 & 15, fq = lane2 >> 4;
#pragma unroll
        for (int m = 0; m < 8; ++m)
#pragma unroll
            for (int n = 0; n < 4; ++n) {
                const int row = mt * 256 + wr * 128 + m * 16 + fr, col = nt * 256 + wc * 64 + n * 16 + fq * 4;
                float* xp = xres + (size_t)row * 1024 + col;
                *(f32x4*)xp = *(const f32x4*)xp + acc[m][n];
            }
    }
}

DEVFI void stage_route(KP p, int l, unsigned char* lds) {
    const int tid = opaque_tid(), lane = tid & 63, wid = tid >> 6, j = lane & 15, kq = lane >> 4;
    unsigned char* ws = p->ws;
    const float* xres = p->out;
    bf16_t* XB = (bf16_t*)(ws + WS_H);
    float* RS = (float*)(ws + WS_RSTD) + NTOK;
    const float* WRT = (const float*)(ws + WS_WRT) + (size_t)l * 48 * 1024;
    const float* brg = (const float*)p->in[26] + l * 4; const float* bre = (const float*)p->in[28] + l * 32;
    int* cnt = (int*)(ws + CTL_CNT) + l * 32;
    int* eid = (int*)(ws + WS_EID); float* ew = (float*)(ws + WS_EW); int* epos = (int*)(ws + WS_EPOS); int* list = (int*)(ws + WS_LIST);
    float* part = (float*)lds;
    float* pss = part + 8 * 16 * 52;
    float* tot = pss + 128;
    int* lcnt = (int*)(tot + 16 * 52);
    int* lbase = lcnt + 32;
    int* lsel = lbase + 32;
    constexpr int MAXG = 8;
    f32x4 wf[3][4][2];
#pragma unroll
    for (int t = 0; t < 3; ++t)
#pragma unroll
        for (int S = 0; S < 4; ++S) {
            wf[t][S][0] = *(const f32x4*)(WRT + (size_t)(16 * t + j) * 1024 + 128 * wid + 32 * S + 8 * kq);
            wf[t][S][1] = *(const f32x4*)(WRT + (size_t)(16 * t + j) * 1024 + 128 * wid + 32 * S + 8 * kq + 4);
        }
    if (tid < 32) lcnt[tid] = 0;
    __syncthreads();
    int ng = 0, grp0 = blockIdx.x;
    for (int grp = blockIdx.x; grp < NTOK / 16; grp += gridDim.x) {
        const int tok = grp * 16 + j;
        const float* xp = xres + (size_t)tok * 1024 + 128 * wid + 8 * kq;
        bf16_t* xbp = XB + (size_t)tok * 1024 + 128 * wid + 8 * kq;
        f32x4 xv[4][2];
#pragma unroll
        for (int S = 0; S < 4; ++S) { xv[S][0] = *(const f32x4*)(xp + 32 * S); xv[S][1] = *(const f32x4*)(xp + 32 * S + 4); }
        f32x4 acc[3] = {{0.f, 0.f, 0.f, 0.f}, {0.f, 0.f, 0.f, 0.f}, {0.f, 0.f, 0.f, 0.f}};
        float ss = 0.f;
#pragma unroll
        for (int S = 0; S < 4; ++S) {
            uint4 o;
            o.x = pk2(xv[S][0][0], xv[S][0][1]); o.y = pk2(xv[S][0][2], xv[S][0][3]); o.z = pk2(xv[S][1][0], xv[S][1][1]); o.w = pk2(xv[S][1][2], xv[S][1][3]);
            *(uint4*)(xbp + 32 * S) = o;
#pragma unroll
            for (int hh = 0; hh < 2; ++hh) {
                ss += xv[S][hh][0] * xv[S][hh][0] + xv[S][hh][1] * xv[S][hh][1] + xv[S][hh][2] * xv[S][hh][2] + xv[S][hh][3] * xv[S][hh][3];
#pragma unroll
                for (int e = 0; e < 4; ++e) {
                    acc[0] = __builtin_amdgcn_mfma_f32_16x16x4f32(wf[0][S][hh][e], xv[S][hh][e], acc[0], 0, 0, 0);
                    acc[1] = __builtin_amdgcn_mfma_f32_16x16x4f32(wf[1][S][hh][e], xv[S][hh][e], acc[1], 0, 0, 0);
                    acc[2] = __builtin_amdgcn_mfma_f32_16x16x4f32(wf[2][S][hh][e], xv[S][hh][e], acc[2], 0, 0, 0);
                }
            }
        }
        ss += __shfl_xor(ss, 16); ss += __shfl_xor(ss, 32);
#pragma unroll
        for (int t = 0; t < 3; ++t) *(f32x4*)(part + (wid * 16 + j) * 52 + t * 16 + kq * 4) = acc[t];
        if (kq == 0) pss[wid * 16 + j] = ss;
        __syncthreads();
        if (tid < 192) {
            const int jj = tid & 15, c = tid >> 4;
            f32x4 sm = *(const f32x4*)(part + jj * 52 + 4 * c);
#pragma unroll
            for (int w = 1; w < 8; ++w) sm = sm + *(const f32x4*)(part + (w * 16 + jj) * 52 + 4 * c);
            *(f32x4*)(tot + jj * 52 + 4 * c) = sm;
            if (c == 0) { float st = 0.f;
#pragma unroll
                for (int w = 0; w < 8; ++w) st += pss[w * 16 + jj];
                tot[jj * 52 + 48] = st; }
        }
        __syncthreads();
        if (tid < 16) {
            const int tk = grp * 16 + tid;
            const float rstd = rsqrtf(tot[tid * 52 + 48] * (1.f / 1024.f) + RMS_EPS);
            RS[tk] = rstd;
            const float* lt = tot + tid * 52;
            float gl[4];
#pragma unroll
            for (int i = 0; i < 4; ++i) gl[i] = lt[i] * rstd + brg[i];
            int gs = 0; float gm = gl[0];
#pragma unroll
            for (int i = 1; i < 4; ++i) if (gl[i] > gm) { gm = gl[i]; gs = i; }
            float gsum = 0.f;
#pragma unroll
            for (int i = 0; i < 4; ++i) gsum += __expf(gl[i] - gm);
            const float gwt = 1.f / gsum;
            float el[8];
            { const f32x4 a = *(const f32x4*)(lt + 4 + gs * 8), bq = *(const f32x4*)(lt + 8 + gs * 8);
              const f32x4 ba = *(const f32x4*)(bre + gs * 8), bb = *(const f32x4*)(bre + gs * 8 + 4);
              el[0] = a[0] * rstd + ba[0]; el[1] = a[1] * rstd + ba[1]; el[2] = a[2] * rstd + ba[2]; el[3] = a[3] * rstd + ba[3];
              el[4] = bq[0] * rstd + bb[0]; el[5] = bq[1] * rstd + bb[1]; el[6] = bq[2] * rstd + bb[2]; el[7] = bq[3] * rstd + bb[3]; }
            int i1 = 0; float m1 = el[0];
#pragma unroll
            for (int i = 1; i < 8; ++i) if (el[i] > m1) { m1 = el[i]; i1 = i; }
            int i2 = -1; float m2 = -__builtin_inff();
#pragma unroll
            for (int i = 0; i < 8; ++i) if (i != i1 && el[i] > m2) { m2 = el[i]; i2 = i; }
            const float e2 = __expf(m2 - m1);
            const float w1 = gwt / (1.f + e2), w2 = gwt * e2 / (1.f + e2);
            const int ea = gs * 8 + i1, eb = gs * 8 + i2;
            eid[tk * 2] = ea; eid[tk * 2 + 1] = eb; ew[tk * 2] = w1; ew[tk * 2 + 1] = w2;
            int* sl = lsel + (ng * 16 + tid) * 4;
            sl[0] = ea; sl[1] = eb; sl[2] = atomicAdd(lcnt + ea, 1); sl[3] = atomicAdd(lcnt + eb, 1);
        }
        ++ng;
        const bool last = grp + (int)gridDim.x >= NTOK / 16;
        if (ng == MAXG || last) {
            __syncthreads();
            if (tid < 32) { const int c = lcnt[tid]; lbase[tid] = c ? atomicAdd(cnt + tid, c) : 0; }
            __syncthreads();
            if (tid < ng * 16) {
                const int tk = (grp0 + (tid >> 4) * (int)gridDim.x) * 16 + (tid & 15);
                const int* sl = lsel + tid * 4;
                const int ea = sl[0], eb = sl[1], pa = lbase[ea] + sl[2], pb = lbase[eb] + sl[3];
                epos[tk * 2] = pa; epos[tk * 2 + 1] = pb;
                list[ea * NTOK + pa] = tk; list[eb * NTOK + pb] = tk;
            }
            __syncthreads();
            if (tid < 32) lcnt[tid] = 0;
            ng = 0; grp0 = grp + (int)gridDim.x;
            __syncthreads();
        }
    }
}

DEVFI bool find_tile(const int* cnt, int ti, int& e, int& mt, int& segstart, int& ecnt) {
    int acc_t = 0, acc_s = 0;
    for (int i = 0; i < 32; ++i) {
        const int c = cnt[i], nt = (c + 255) >> 8;
        if (ti < acc_t + nt) { e = i; mt = ti - acc_t; segstart = acc_s; ecnt = c; return true; }
        acc_t += nt; acc_s += nt << 8;
    }
    return false;
}

DEVFI void stage_gateup(KP p, int l, unsigned char* lds) {
    unsigned char* ws = p->ws;
    const bf16_t* H = (const bf16_t*)(ws + WS_H);
    const bf16_t* EG = (const bf16_t*)(ws + WS_EG) + (size_t)l * 32 * 512 * 1024; const bf16_t* EU = (const bf16_t*)(ws + WS_EU) + (size_t)l * 32 * 512 * 1024;
    const int* cnt = (const int*)(ws + CTL_CNT) + l * 32;
    const int* list = (const int*)(ws + WS_LIST);
    const float* RS = (const float*)(ws + WS_RSTD) + NTOK;
    bf16_t* ACT = (bf16_t*)(ws + WS_ACT);
    for (int u = blockIdx.x;; u += gridDim.x) {
        const int tid = opaque_tid();
        const int ti = u >> 2, nt = u & 3;
        int e, mt, seg, ec;
        if (!find_tile(cnt, ti, e, mt, seg, ec)) break;
        int r0 = mt * 256 + (tid >> 2), r1 = r0 + 128;
        if (r0 >= ec) r0 = 0;
        if (r1 >= ec) r1 = 0;
        const int tk0 = list[e * NTOK + r0], tk1 = list[e * NTOK + r1];
        const bf16_t* a0 = H + (size_t)tk0 * 1024 + SWZ_CHUNK(tid);
        const bf16_t* a1 = H + (size_t)tk1 * 1024 + SWZ_CHUNK(tid);
        const int brow = tid >> 2, sub = brow >> 4;
        const bf16_t* b0 = ((sub & 1) ? EU : EG) + ((size_t)e * 512 + nt * 128 + (sub >> 1) * 16 + (brow & 15)) * 1024 + SWZ_CHUNK(tid);
        const bf16_t* b1 = ((sub & 1) ? EU : EG) + ((size_t)e * 512 + nt * 128 + ((sub + 8) >> 1) * 16 + (brow & 15)) * 1024 + SWZ_CHUNK(tid);
        f32x4 acc[8][4];
        gemm_tile8(lds, a0, a1, b0, b1, 32, acc);
        const int tid2 = opaque_tid(), lane2 = tid2 & 63, wid2 = tid2 >> 6, wr = wid2 >> 2, wc = wid2 & 3, fr = lane2 & 15, fq = lane2 >> 4;
#pragma unroll
        for (int m = 0; m < 8; ++m) {
            const int rl = mt * 256 + wr * 128 + m * 16 + fr;
            const float rs = RS[list[e * NTOK + (rl < ec ? rl : 0)]];
#pragma unroll
            for (int n = 0; n < 4; n += 2) {
                const int col = nt * 128 + (wc * 2 + (n >> 1)) * 16 + fq * 4;
                float o[4];
#pragma unroll
                for (int r = 0; r < 4; ++r) { const float g = acc[m][n][r] * rs; o[r] = g * sigmoidf_(g) * (acc[m][n + 1][r] * rs); }
                uint2 w; w.x = pk2(o[0], o[1]); w.y = pk2(o[2], o[3]);
                *(uint2*)(ACT + (size_t)(seg + rl) * 512 + col) = w;
            }
        }
    }
}

DEVFI void stage_down(KP p, int l, unsigned char* lds) {
    unsigned char* ws = p->ws;
    const bf16_t* ACT = (const bf16_t*)(ws + WS_ACT);
    const bf16_t* ED = (const bf16_t*)(ws + WS_ED) + (size_t)l * 32 * 1024 * 512;
    const int* cnt = (const int*)(ws + CTL_CNT) + l * 32;
    bf16_t* Y = (bf16_t*)(ws + WS_Y);
    for (int u = blockIdx.x;; u += gridDim.x) {
        const int tid = opaque_tid();
        const int ti = u >> 2, nt = u & 3;
        int e, mt, seg, ec;
        if (!find_tile(cnt, ti, e, mt, seg, ec)) break;
        const bf16_t* a0 = ACT + (size_t)(seg + mt * 256 + (tid >> 2)) * 512 + SWZ_CHUNK(tid);
        const bf16_t* b0 = ED + ((size_t)e * 1024 + nt * 256 + (tid >> 2)) * 512 + SWZ_CHUNK(tid);
        f32x4 acc[8][4];
        gemm_tile8(lds, a0, a0 + (size_t)128 * 512, b0, b0 + (size_t)128 * 512, 16, acc);
        const int tid2 = opaque_tid(), lane2 = tid2 & 63, wid2 = tid2 >> 6, wr = wid2 >> 2, wc = wid2 & 3, fr = lane2 & 15, fq = lane2 >> 4;
#pragma unroll
        for (int m = 0; m < 8; ++m)
#pragma unroll
            for (int n = 0; n < 4; ++n) {
                const int slot = seg + mt * 256 + wr * 128 + m * 16 + fr, col = nt * 256 + wc * 64 + n * 16 + fq * 4;
                uint2 w; w.x = pk2(acc[m][n][0], acc[m][n][1]); w.y = pk2(acc[m][n][2], acc[m][n][3]);
                *(uint2*)(Y + (size_t)slot * 1024 + col) = w;
            }
    }
}

__global__ void __launch_bounds__(512) mega(Params p0) {
    extern __shared__ __attribute__((aligned(16))) unsigned char lds[];
    volatile LAS unsigned* ctl = (volatile LAS unsigned*)(LAS unsigned char*)(lds + LDS_CTL);
    if (threadIdx.x < 64) ctl[threadIdx.x] = 0u;
    __syncthreads();
    XcdBarrier bar; bar.bar = (unsigned*)p0.ws; bar.x = 0; bar.st = ctl;
    const bool multi = (p0.ph_hi - p0.ph_lo) > 1;
    if (multi) bar = xcd_barrier_post((unsigned*)p0.ws, ctl);
#if PROBE_MASK || PROBE_INNER
    unsigned long long pr_prev = __builtin_amdgcn_s_memrealtime(), pr_acc = 0ull;
#endif
    for (int ph = p0.ph_lo; ph < p0.ph_hi; ++ph) {
        KP p = (KP)__builtin_amdgcn_kernarg_segment_ptr();
#if PROBE_INNER
        { const int kind_ = ph < NPRE ? ph : (ph == NPHASE - 1 ? 11 : 2 + (ph - NPRE) % NST);
          if (threadIdx.x == 0) *(volatile unsigned*)(lds + LDS_CTL + 36) = (PROBE_INNER >> kind_) & 1; }
        __syncthreads();
#endif
        asm volatile("" : "+s"(p));
#ifndef ONLY
#define ONLY -1
#endif
#ifndef SKIP
#define SKIP -1
#endif
#define RUN(k) ((ONLY < 0 || ONLY == (k)) && SKIP != (k))
        if (ph == 0) { if (RUN(100)) phase_prep(p, lds); }
        else if (ph == 1) { if (RUN(101)) phase_prep1(p); }
        else if (ph == NPHASE - 1) { if (RUN(0)) stage_norm1(p, DEPTH, true); }
        else {
            const int l = (ph - NPRE) / NST, s = (ph - NPRE) % NST;
            switch (s) {
                case 0: if (RUN(0)) stage_norm1(p, l, false); break;
                case 1: if (RUN(1)) stage_inproj(p, l, lds); break;
                case 2: if (RUN(2)) stage_posta(p, l, lds); break;
                case 3: if (RUN(4)) { stage_attn(p, l, lds); stage_glu(p, l, lds); } break;
                case 4: if (RUN(6)) stage_merge(p, l, lds); break;
                case 5: if (RUN(7)) stage_out(p, l, lds); break;
                case 6: if (RUN(8)) stage_route(p, l, lds); break;
                case 7: if (RUN(9)) stage_gateup(p, l, lds); break;
                default: if (RUN(10)) stage_down(p, l, lds); break;
            }
        }
        if (ph + 1 < p0.ph_hi) xcd_barrier(bar);
#if PROBE_MASK || PROBE_INNER
        {
            const int kind = ph < NPRE ? ph : (ph == NPHASE - 1 ? 11 : 2 + (ph - NPRE) % NST);
            const unsigned long long now = __builtin_amdgcn_s_memrealtime();
            if ((PROBE_MASK >> kind) & 1) pr_acc += now - pr_prev;
            pr_prev = now;
        }
#endif
    }
#if PROBE_MASK || PROBE_INNER
#if PROBE_INNER
    __syncthreads();
    pr_acc += *(volatile unsigned*)(lds + LDS_CTL + 32);
#endif
    if (blockIdx.x == 0) { const unsigned long long t0 = __builtin_amdgcn_s_memrealtime(); while (__builtin_amdgcn_s_memrealtime() - t0 < pr_acc) __builtin_amdgcn_s_sleep(8); }
#endif
}

extern "C" void kernel_launch(void* const* d_in, const int* in_sizes, int n_in, void* d_out, int out_size, void* d_ws, size_t ws_size, hipStream_t stream) {
    static int grid = 0;
    if (grid == 0) {
        if (n_in != 32 || out_size != NTOK * D || ws_size < WS_END) {
            fprintf(stderr, "kernel_launch: unexpected problem: n_in %d out %d ws %zu (need %zu)\n", n_in, out_size, ws_size, (size_t)WS_END);
            grid = -1; return;
        }
        int dev = 0, cus = 0, per_cu = 0;
        hipGetDevice(&dev);
        hipDeviceGetAttribute(&cus, hipDeviceAttributeMultiprocessorCount, dev);
        hipFuncSetAttribute((const void*)mega, hipFuncAttributeMaxDynamicSharedMemorySize, LDS_BYTES);
        hipOccupancyMaxActiveBlocksPerMultiprocessor(&per_cu, (const void*)mega, 512, LDS_BYTES);
        (void)hipGetLastError();
        if (per_cu < 1) { fprintf(stderr, "kernel_launch: occupancy query says %d blocks per CU\n", per_cu); grid = -1; return; }
        grid = cus;
    }
    if (grid < 0) return;
    hipMemsetAsync(d_ws, 0, CTL_BYTES, stream);
    Params p{};
    for (int i = 0; i < 32; ++i) p.in[i] = d_in[i];
    p.out = (float*)d_out; p.ws = (unsigned char*)d_ws;
#if MK_SPLIT
    for (int ph = 0; ph < NPHASE; ++ph) {
        p.ph_lo = ph; p.ph_hi = ph + 1;
        hipLaunchKernelGGL(mega, dim3(grid), dim3(512), LDS_BYTES, stream, p);
    }
#else
    p.ph_lo = 0; p.ph_hi = NPHASE;
    void* args[] = {&p};
    hipError_t e = hipLaunchCooperativeKernel((const void*)mega, dim3(grid), dim3(512), args, LDS_BYTES, stream);
    if (e != hipSuccess) fprintf(stderr, "kernel_launch: cooperative launch failed: %s (grid %d)\n", hipGetErrorString(e), grid);
#endif
    (void)in_sizes;
}
```

```cpp
#include <hip/hip_runtime.h>
#include <cstdint>
#include <cstdio>

#ifndef PROBE_MASK
#define PROBE_INNER 0
#define PROBE_MASK 0
#endif
#ifndef MK_SPLIT
#define MK_SPLIT 0
#endif

#define DEVFI __device__ __forceinline__
#define LAS __attribute__((address_space(3)))
typedef unsigned short bf16_t;
typedef short bf16x8 __attribute__((ext_vector_type(8)));
typedef float f32x4 __attribute__((ext_vector_type(4)));
typedef float f32x16 __attribute__((ext_vector_type(16)));
typedef short s16x4 __attribute__((ext_vector_type(4)));

constexpr int D = 1024, BATCH = 8, SEQ = 2048, NTOK = BATCH * SEQ, DEPTH = 4;
constexpr int NH = 8, NKV = 2, HD = 64;
constexpr int NCMP = 127;
constexpr int IN_COLS = 3608, ZN = 3840;
constexpr int ZC_Q = 0, ZC_KC = 512, ZC_VC = 640, ZC_KS = 768, ZC_VS = 896, ZC_KW = 1024, ZC_VW = 1152, ZC_U = 1280, ZC_GA = 1536, ZC_GS = 2560, ZC_NG = 3584;
constexpr int SC_NG = 1280, SC_U = 1304, SC_GA = 1560, SC_GS = 2584;
constexpr int NEXP = 32, FF = 512;
constexpr int A_PAD = NTOK * 2 + NEXP * 256;
constexpr float RMS_EPS = 1e-6f;

constexpr size_t al256(size_t x) { return (x + 255) & ~(size_t)255; }
constexpr size_t CTL_BYTES = 65536;
constexpr size_t CTL_CNT = 16384;
constexpr size_t WS_ROPE = CTL_BYTES;
constexpr size_t WS_S5LB = al256(WS_ROPE + (size_t)NTOK * 16 * 4);
constexpr size_t WS_S5BB = al256(WS_S5LB + (size_t)DEPTH * 16 * 64 * 2 * 4);
constexpr size_t WS_CB1 = al256(WS_S5BB + (size_t)DEPTH * 16 * 64 * 16 * 2 * 4);
constexpr size_t WS_WIN = al256(WS_CB1 + (size_t)DEPTH * 2 * 128 * 4);
constexpr size_t WS_CW1 = al256(WS_WIN + (size_t)DEPTH * ZN * 1024 * 2);
constexpr size_t WS_GLU = al256(WS_CW1 + (size_t)DEPTH * 2 * 128 * 2048 * 2);
constexpr size_t WS_PA = al256(WS_GLU + (size_t)DEPTH * 512 * 256 * 2);
constexpr size_t WS_PS = al256(WS_PA + (size_t)DEPTH * 1024 * 512 * 2);
constexpr size_t WS_WO = al256(WS_PS + (size_t)DEPTH * 1024 * 256 * 2);
constexpr size_t WS_EG = al256(WS_WO + (size_t)DEPTH * 1024 * 1024 * 2);
constexpr size_t WS_EU = al256(WS_EG + (size_t)DEPTH * 32 * 512 * 1024 * 2);
static_assert(WS_EU == WS_EG + (size_t)DEPTH * 32 * 512 * 1024 * 2, "EG and EU regions are contiguous");
constexpr size_t WS_ED = al256(WS_EU + (size_t)DEPTH * 32 * 512 * 1024 * 2);
constexpr size_t WS_H = al256(WS_ED + (size_t)DEPTH * 32 * 1024 * 512 * 2);
constexpr size_t WS_Z = al256(WS_H + (size_t)NTOK * 1024 * 2);
constexpr size_t WS_HID = al256(WS_Z + (size_t)NTOK * ZN * 2);
constexpr size_t WS_KC = al256(WS_HID + (size_t)2 * 2048 * 128 * 2);
constexpr size_t WS_VC = al256(WS_KC + (size_t)BATCH * 2 * 128 * 64 * 4);
constexpr size_t WS_YB = al256(WS_VC + (size_t)BATCH * 2 * 128 * 64 * 4);
constexpr size_t WS_OB = al256(WS_YB + (size_t)NTOK * 256 * 2);
constexpr size_t WS_OA = al256(WS_OB + (size_t)NTOK * 256 * 2);
constexpr size_t WS_OCMP = al256(WS_OA + (size_t)NTOK * 512 * 2);
constexpr size_t WS_POW = WS_OCMP;
constexpr size_t WS_KTAB = al256(WS_POW + (size_t)DEPTH * 16 * 64 * 65 * 8);
constexpr size_t WS_CW2T = al256(WS_KTAB + (size_t)DEPTH * 16 * 66 * 256 * 2);
static_assert(al256(WS_CW2T + (size_t)DEPTH * 2 * 64 * 128 * 2) <= WS_OCMP + (size_t)NTOK * 512 * 4, "S5 tables fit the old OCMP region");
constexpr size_t WS_SC = al256(WS_OCMP + (size_t)NTOK * 512 * 4);
constexpr size_t WS_MSTATE = WS_SC;
constexpr size_t WS_PCS = al256(WS_SC + (size_t)BATCH * 2 * SEQ * 128 * 4);
constexpr size_t WS_MCARRY = WS_PCS;
constexpr size_t WS_IMP = al256(WS_PCS + (size_t)BATCH * 2 * SEQ * 128 * 4);
constexpr size_t WS_RSTD = WS_IMP;
constexpr size_t WS_WRT = al256(WS_RSTD + (size_t)2 * NTOK * 4);
static_assert(WS_WRT + (size_t)DEPTH * 48 * 1024 * 4 <= WS_IMP + (size_t)BATCH * 2 * SEQ * 32 * 4, "fits the old IMP region");
constexpr size_t WS_SEL = al256(WS_IMP + (size_t)BATCH * 2 * SEQ * 32 * 4);
constexpr size_t WS_EID = al256(WS_SEL + (size_t)BATCH * 2 * SEQ * 4);
constexpr size_t WS_EW = al256(WS_EID + (size_t)NTOK * 2 * 4);
constexpr size_t WS_EPOS = al256(WS_EW + (size_t)NTOK * 2 * 4);
constexpr size_t WS_LIST = al256(WS_EPOS + (size_t)NTOK * 2 * 4);
constexpr size_t WS_MRG = al256(WS_LIST + (size_t)32 * NTOK * 4);
constexpr size_t WS_ACT = al256(WS_MRG + (size_t)NTOK * 1024 * 2);
constexpr size_t WS_Y = al256(WS_ACT + (size_t)A_PAD * 512 * 2);
constexpr size_t WS_KCB = al256(WS_Y + (size_t)A_PAD * 1024 * 2);
constexpr size_t WS_VCB = al256(WS_KCB + (size_t)BATCH * 2 * 128 * 64 * 2);
constexpr size_t WS_S5X = WS_MRG;
constexpr size_t WS_END = al256(WS_VCB + (size_t)BATCH * 2 * 128 * 64 * 2);
static_assert(WS_S5X + (size_t)NTOK * 16 * 128 * 4 <= WS_END, "S5X alias must fit");

constexpr int LDS_STAGE = 147456;
constexpr int LDS_CTL = LDS_STAGE;
constexpr int LDS_BYTES = LDS_STAGE + 512;

constexpr int NST = 9;
constexpr int NPRE = 2;
constexpr int NPHASE = NPRE + DEPTH * NST + 1;

struct Params {
    const void* in[32];
    float* out;
    unsigned char* ws;
    int ph_lo, ph_hi;
};
typedef const __attribute__((address_space(4))) Params* KP;

DEVFI int lane_id_v() { int l; asm volatile("v_mbcnt_lo_u32_b32 %0, -1, 0\n\tv_mbcnt_hi_u32_b32 %0, -1, %0" : "=&v"(l)); return l; }
DEVFI int hw_wave_slot() { return (int)__builtin_amdgcn_s_getreg((4) | (0 << 6) | (5 << 11)); }
#define LDS_WVTAB_ADDR (LDS_STAGE + 256)
DEVFI int opaque_tid() {
    const int wv = *(volatile LAS int*)(LAS unsigned char*)(unsigned)(LDS_WVTAB_ADDR + 4 * hw_wave_slot());
    return wv * 64 + lane_id_v();
}
DEVFI float xshfl(float v, int m) { return __int_as_float(__builtin_amdgcn_ds_bpermute((lane_id_v() ^ m) << 2, __float_as_int(v))); }
DEVFI int xshfl_i(int v, int m) { return __builtin_amdgcn_ds_bpermute((lane_id_v() ^ m) << 2, v); }
DEVFI float opaque_zero() { float z = 0.f; asm volatile("" : "+v"(z)); return z; }
DEVFI float bf2f(bf16_t v) { return __uint_as_float((unsigned)v << 16); }
DEVFI unsigned f2bf(float f) { unsigned u = __float_as_uint(f); return (u + 0x7fffu + ((u >> 16) & 1u)) >> 16; }
typedef __bf16 bf16v2_t __attribute__((ext_vector_type(2)));
typedef float f32v2_t __attribute__((ext_vector_type(2)));
DEVFI unsigned pk2(float lo, float hi) { const f32v2_t v = {lo, hi}; return __builtin_bit_cast(unsigned, __builtin_convertvector(v, bf16v2_t)); }
DEVFI float wave_sum(float v) {
#pragma unroll
    for (int o = 1; o < 64; o <<= 1) v += xshfl(v, o);
    return v;
}
DEVFI float sigmoidf_(float x) { return 1.f / (1.f + __expf(-x)); }
DEVFI float gelu_tanh(float x) { return 0.5f * x * (1.f + tanhf(0.7978845608028654f * (x + 0.044715f * x * x * x))); }
DEVFI void unpack8(uint4 v, float* f) {
    f[0] = __uint_as_float(v.x << 16); f[1] = __uint_as_float(v.x & 0xffff0000u);
    f[2] = __uint_as_float(v.y << 16); f[3] = __uint_as_float(v.y & 0xffff0000u);
    f[4] = __uint_as_float(v.z << 16); f[5] = __uint_as_float(v.z & 0xffff0000u);
    f[6] = __uint_as_float(v.w << 16); f[7] = __uint_as_float(v.w & 0xffff0000u);
}

#define XB_TMO      128
#define XB_XCNT(j)  (256  + 64 * (j))
#define XB_XSUB(j)  (1280 + 64 * (j))
#define XB_XGEN(j)  (2304 + 64 * (j))
#define XB_TOP      3328
#define XB_TOPGEN   3392
#define XCD_BAR_WORDS 3456
#define XB_SPIN_CAP (1u << 22)
DEVFI unsigned xb_ld(unsigned* p) { return __hip_atomic_load(p, __ATOMIC_RELAXED, __HIP_MEMORY_SCOPE_AGENT); }
DEVFI unsigned xb_add(unsigned* p, unsigned v) { return __hip_atomic_fetch_add(p, v, __ATOMIC_RELAXED, __HIP_MEMORY_SCOPE_AGENT); }
DEVFI unsigned xb_xcc_id() { return (unsigned)__builtin_amdgcn_s_getreg((3 << 11) | 20) & 0xFu; }
#define XB_SPIN(cond, bar) do { unsigned _sp = 0; while (cond) { __builtin_amdgcn_s_sleep(1); \
    if ((++_sp & 255u) == 0u) { if (xb_ld(&(bar)[XB_TMO])) break; if (_sp > XB_SPIN_CAP) { atomicAdd(&(bar)[XB_TMO], 1u); break; } } } } while (0)
struct XcdBarrier { unsigned* bar; unsigned x; volatile LAS unsigned* st; };
DEVFI XcdBarrier xcd_barrier_post(unsigned* bar, volatile LAS unsigned* st) {
    XcdBarrier b; b.bar = bar; b.x = xb_xcc_id(); b.st = st;
    if (opaque_tid() == 0) (void)xb_add(&bar[XB_XCNT(b.x)], 1u);
    return b;
}
DEVFI void xcd_barrier_complete(unsigned* bar, unsigned x, unsigned& nloc, unsigned& nx) {
    const unsigned G = gridDim.x * gridDim.y * gridDim.z;
    unsigned sum, cnt, mine, sp = 0u;
    for (;;) {
        sum = 0u; cnt = 0u; mine = 0u;
#pragma unroll
        for (unsigned j = 0; j < 16; ++j) { const unsigned c = xb_ld(&bar[XB_XCNT(j)]); sum += c; cnt += (c > 0u) ? 1u : 0u; mine = (j == x) ? c : mine; }
        if (sum == G) break;
        __builtin_amdgcn_s_sleep(1);
        if ((++sp & 255u) == 0u) { if (xb_ld(&bar[XB_TMO])) break; if (sp > XB_SPIN_CAP) { atomicAdd(&bar[XB_TMO], 1u); break; } }
    }
    nloc = mine > 0u ? mine : 1u; nx = cnt > 0u ? cnt : 1u;
}
DEVFI void xcd_barrier(const XcdBarrier& b) {
    asm volatile("s_waitcnt vmcnt(0)" ::: "memory");
    __syncthreads();
    if (opaque_tid() == 0) {
        unsigned* bar = b.bar;
        __builtin_amdgcn_s_waitcnt(0);
        unsigned nloc = b.st[0], nx = b.st[1];
        if (nloc == 0u) { xcd_barrier_complete(bar, b.x, nloc, nx); b.st[0] = nloc; b.st[1] = nx; }
        const unsigned old = xb_add(&bar[XB_XSUB(b.x)], 1u);
        const unsigned gen = old / nloc;
        if (old + 1u == (gen + 1u) * nloc) {
            __builtin_amdgcn_fence(__ATOMIC_RELEASE, "agent");
            asm volatile("s_waitcnt vmcnt(0)" ::: "memory");
            const unsigned og = xb_add(&bar[XB_TOP], 1u);
            const unsigned tg = og / nx;
            if (og + 1u == (tg + 1u) * nx) xb_add(&bar[XB_TOPGEN], 1u);
            else XB_SPIN(xb_ld(&bar[XB_TOPGEN]) == tg, bar);
            __builtin_amdgcn_fence(__ATOMIC_ACQUIRE, "agent");
            xb_add(&bar[XB_XGEN(b.x)], 1u);
            asm volatile("s_waitcnt vmcnt(0)" ::: "memory");
        } else {
            XB_SPIN(xb_ld(&bar[XB_XGEN(b.x)]) == gen, bar);
            __builtin_amdgcn_fence(__ATOMIC_ACQUIRE, "agent");
            asm volatile("s_waitcnt vmcnt(0)" ::: "memory");
        }
    }
    __syncthreads();
}

#define SWZ_CHUNK(tid) ((((tid) & 3) ^ ((((tid) >> 5) & 1) << 1)) * 8)
DEVFI void glds16(const bf16_t* g, unsigned char* l) {
    __builtin_amdgcn_global_load_lds((const unsigned*)g, (unsigned*)l, 16, 0, 0);
}
template <int NB>
DEVFI void gemm_tile(unsigned char* lds, const bf16_t* a0, const bf16_t* a1, int a_kstride,
                     const bf16_t* b0, const bf16_t* b1, int nk, f32x4 (&acc)[NB][4][4]) {
    static_assert(NB == 1, "three-stage ring is sized for one B tile");
    const int tid = opaque_tid(), lane = tid & 63, wid = tid >> 6;
    const int wr = wid >> 1, wc = wid & 1, fr = lane & 15, fq = lane >> 4;
    const int fsw = (fq ^ (((fr >> 3) & 1) << 1)) * 16;
    constexpr int STAGE = 32768 + 16384;
    const float fz = opaque_zero();
#pragma unroll
    for (int m = 0; m < 4; ++m)
#pragma unroll
        for (int n = 0; n < 4; ++n) acc[0][m][n] = (f32x4){fz, fz, fz, fz};
    auto stage = [&](int kt, int buf) {
        unsigned char* s = lds + buf * STAGE + tid * 16;
        const bf16_t* pa0 = a0 + (size_t)kt * a_kstride;
        const bf16_t* pa1 = a1 + (size_t)kt * a_kstride;
#pragma unroll
        for (int pq = 0; pq < 2; ++pq) {
            glds16(pa0 + pq * 32, s + pq * 16384);
            glds16(pa1 + pq * 32, s + pq * 16384 + 8192);
            glds16(b0 + kt * 64 + pq * 32, s + 32768 + pq * 8192);
        }
    };
    stage(0, 0);
    if (nk > 1) stage(1, 1);
    int buf = 0;
    for (int kt = 0; kt < nk; ++kt) {
        if (kt + 1 < nk) asm volatile("s_waitcnt vmcnt(6)" ::: "memory"); else asm volatile("s_waitcnt vmcnt(0)" ::: "memory");
        __builtin_amdgcn_s_barrier();
        asm volatile("" ::: "memory");
        if (kt + 2 < nk) { const int nb = buf >= 1 ? buf - 1 : 2; stage(kt + 2, nb); }
        const unsigned char* s = lds + buf * STAGE;
#pragma unroll
        for (int pq = 0; pq < 2; ++pq) {
            bf16x8 af[4], bfr[4];
#pragma unroll
            for (int m = 0; m < 4; ++m) af[m] = *(const bf16x8*)(s + pq * 16384 + (wr * 64 + m * 16 + fr) * 64 + fsw);
#pragma unroll
            for (int n = 0; n < 4; ++n) bfr[n] = *(const bf16x8*)(s + 32768 + pq * 8192 + (wc * 64 + n * 16 + fr) * 64 + fsw);
#pragma unroll
            for (int m = 0; m < 4; ++m)
#pragma unroll
                for (int n = 0; n < 4; ++n) acc[0][m][n] = __builtin_amdgcn_mfma_f32_16x16x32_bf16(bfr[n], af[m], acc[0][m][n], 0, 0, 0);
        }
        buf = buf == 2 ? 0 : buf + 1;
    }
    asm volatile("s_waitcnt lgkmcnt(0)" ::: "memory");
    __builtin_amdgcn_s_barrier();
    asm volatile("" ::: "memory");
    (void)b1;
}

#ifndef PROBE_INNER
#define PROBE_INNER 0
#endif
template <int NF>
DEVFI void gemm_pro(unsigned char* lds, const bf16_t* a0, const bf16_t* a1, const bf16_t* b0, const bf16_t* b1, int nk) {
    const int tid = opaque_tid();
    constexpr int STAGE = 16384 + NF * 4096;
#pragma unroll
    for (int kt = 0; kt < 3; ++kt) if (kt < nk) {
        unsigned char* s = lds + kt * STAGE + tid * 16;
        glds16(a0 + kt * 32, s);
        glds16(a1 + kt * 32, s + 8192);
        glds16(b0 + kt * 32, s + 16384);
        if (NF == 4) glds16(b1 + kt * 32, s + 16384 + 8192);
    }
}
template <int NF>
DEVFI void gemm_main(unsigned char* lds, const bf16_t* a0, const bf16_t* a1, const bf16_t* b0, const bf16_t* b1, int nk, f32x4 (&acc)[8][NF]) {
#if PROBE_INNER
    const unsigned long long pi_t0 = __builtin_amdgcn_s_memrealtime();
#endif
    const int tid = opaque_tid(), lane = tid & 63, wid = tid >> 6;
    const int grp = __builtin_amdgcn_readfirstlane(wid) >> 2;
    const int wr = wid >> 2, wc = wid & 3, fr = lane & 15, fq = lane >> 4;
    const int fsw = (fq ^ (((fr >> 3) & 1) << 1)) * 16;
    constexpr int STAGE = 16384 + NF * 4096;
    const float fz = opaque_zero();
#pragma unroll
    for (int m = 0; m < 8; ++m)
#pragma unroll
        for (int n = 0; n < NF; ++n) acc[m][n] = (f32x4){fz, fz, fz, fz};
#define GEMM_WAIT_YOUNGER(nyoung) do { \
        if (NF == 4) { if ((nyoung) >= 2) asm volatile("s_waitcnt vmcnt(8)" ::: "memory"); else if ((nyoung) == 1) asm volatile("s_waitcnt vmcnt(4)" ::: "memory"); else asm volatile("s_waitcnt vmcnt(0)" ::: "memory"); } \
        else         { if ((nyoung) >= 2) asm volatile("s_waitcnt vmcnt(6)" ::: "memory"); else if ((nyoung) == 1) asm volatile("s_waitcnt vmcnt(3)" ::: "memory"); else asm volatile("s_waitcnt vmcnt(0)" ::: "memory"); } } while (0)
    GEMM_WAIT_YOUNGER(nk - 1);
    __builtin_amdgcn_s_barrier();
    if (grp == 1) __builtin_amdgcn_s_barrier();
    __builtin_amdgcn_sched_barrier(0);
    for (int kt = 0; kt < nk; ++kt) {
        if (kt + 3 < nk) {
            unsigned char* s = lds + ((kt + 3) & 3) * STAGE + tid * 16;
            glds16(a0 + (kt + 3) * 32, s);
            glds16(a1 + (kt + 3) * 32, s + 8192);
            glds16(b0 + (kt + 3) * 32, s + 16384);
            if (NF == 4) glds16(b1 + (kt + 3) * 32, s + 16384 + 8192);
        }
        const unsigned char* s = lds + (kt & 3) * STAGE;
        bf16x8 af[8], bfr[NF];
#pragma unroll
        for (int n = 0; n < NF; ++n) bfr[n] = *(const bf16x8*)(s + 16384 + (wc * 16 * NF + n * 16 + fr) * 64 + fsw);
#pragma unroll
        for (int m = 0; m < 8; ++m) af[m] = *(const bf16x8*)(s + (wr * 128 + m * 16 + fr) * 64 + fsw);
        { const int ny = (kt + 3 < nk) ? 2 : ((kt + 2 < nk) ? 1 : 0); GEMM_WAIT_YOUNGER(ny); }
        asm volatile("s_waitcnt lgkmcnt(0)" ::: "memory");
        __builtin_amdgcn_s_barrier();
        __builtin_amdgcn_sched_barrier(0);
#pragma unroll
        for (int m = 0; m < 8; ++m)
#pragma unroll
            for (int n = 0; n < NF; ++n) acc[m][n] = __builtin_amdgcn_mfma_f32_16x16x32_bf16(bfr[n], af[m], acc[m][n], 0, 0, 0);
        __builtin_amdgcn_sched_barrier(0);
        __builtin_amdgcn_s_barrier();
        __builtin_amdgcn_sched_barrier(0);
    }
    if (grp == 0) __builtin_amdgcn_s_barrier();
    asm volatile("" ::: "memory");
#undef GEMM_WAIT_YOUNGER
#if PROBE_INNER
    if (opaque_tid() == 0) { volatile unsigned* w = (volatile unsigned*)(lds + LDS_CTL + 32); if (w[1]) *w = *w + (unsigned)(__builtin_amdgcn_s_memrealtime() - pi_t0); }
#endif
}
template <int NF>
DEVFI void gemm_tile8(unsigned char* lds, const bf16_t* a0, const bf16_t* a1, const bf16_t* b0, const bf16_t* b1, int nk, f32x4 (&acc)[8][NF]) {
    gemm_pro<NF>(lds, a0, a1, b0, b1, nk);
    gemm_main<NF>(lds, a0, a1, b0, b1, nk, acc);
}


namespace pg8 {
constexpr int BK = 64, HALF = 128, HTB = HALF * BK * 2;
DEVFI int lds_byte(int r, int c) { const int st = (r >> 4) * 2 + (c >> 5), rr = r & 15, cc = c & 31, ob = rr * 64 + cc * 2; return st * 1024 + (ob ^ (((ob >> 9) & 1) << 5)); }
DEVFI void stage_rc(int b, int& R, int& C) { const int st = b / 1024, sb = b % 1024, swz = sb ^ (((sb >> 9) & 1) << 5); R = (st >> 1) * 16 + swz / 64; C = (st & 1) * 32 + (swz % 64) / 2; }
struct Unit { const char* a; const char* b; int r0, c0, x0, x1; };
template <class Epi, class Sched, bool GATHER = false>
DEVFI void gemm_phase(unsigned char* lds_g, const int K, const Sched& S, const Epi& E) {
    LAS unsigned char* lds = (LAS unsigned char*)lds_g;
    const int tid = opaque_tid(), wid = __builtin_amdgcn_readfirstlane(tid >> 6), lane = tid & 63, wr = wid >> 2, wc = wid & 3, fr = lane & 15, fq = lane >> 4;
    const int nt = K / BK;
    unsigned voff[2];
#pragma unroll
    for (int i = 0; i < 2; ++i) { int R, C; stage_rc(tid * 16 + i * 8192, R, C); voff[i] = (unsigned)(R * K + C) * 2u; }
    const size_t kstep = (size_t)(BK * 2);
    const size_t hstep = (size_t)HALF * K * 2;
    const unsigned ldsw = (unsigned)wid * 1024u;
    const int aoff = lds_byte(wr * 64 + fr, fq * 8), boff = lds_byte(wc * 32 + fr, fq * 8);
#define PG8_SA(b, h) (((b) * 2 + (h)) * HTB)
#define PG8_SB(b, h) ((4 + (b) * 2 + (h)) * HTB)
#define PG8_STAGE(bufoff, gbase) do { _Pragma("unroll") for (int _i = 0; _i < 2; ++_i) \
        __builtin_amdgcn_global_load_lds((const unsigned*)((const char*)(gbase) + voff[_i]), (LAS unsigned*)(lds + (bufoff) + ldsw + _i * 8192), 16, 0, 0); } while (0)
#define PG8_STAGE_A(bufoff, UP, PP, h, koff) do { if constexpr (GATHER) { _Pragma("unroll") for (int _i = 0; _i < 2; ++_i) \
        __builtin_amdgcn_global_load_lds((const unsigned*)(gbase + (koff) + PP[h][_i]), (LAS unsigned*)(lds + (bufoff) + ldsw + _i * 8192), 16, 0, 0); } \
        else PG8_STAGE(bufoff, (UP) + (h) * hstep + (koff)); } while (0)
#define PG8_LDA(dst, b, h) do { _Pragma("unroll") for (int m = 0; m < 4; ++m) _Pragma("unroll") for (int k = 0; k < 2; ++k) dst[m][k] = *(const LAS bf16x8*)(lds + PG8_SA(b, h) + aoff + m * 2048 + k * 1024); } while (0)
#define PG8_LDB(dst, b, h) do { _Pragma("unroll") for (int n = 0; n < 2; ++n) _Pragma("unroll") for (int k = 0; k < 2; ++k) dst[n][k] = *(const LAS bf16x8*)(lds + PG8_SB(b, h) + boff + n * 2048 + k * 1024); } while (0)
#define PG8_MMA(ai, bj, At, Bt) do { __builtin_amdgcn_s_setprio(1); _Pragma("unroll") for (int m = 0; m < 4; ++m) _Pragma("unroll") for (int n = 0; n < 2; ++n) _Pragma("unroll") for (int k = 0; k < 2; ++k) \
        acc[ai][bj][m][n] = __builtin_amdgcn_mfma_f32_16x16x32_bf16(Bt[n][k], At[m][k], acc[ai][bj][m][n], 0, 0, 0); __builtin_amdgcn_s_setprio(0); } while (0)
#define PG8_WAIT_V(n) asm volatile("s_waitcnt vmcnt(" #n ")" ::: "memory")
#define PG8_WAIT_L(n) asm volatile("s_waitcnt lgkmcnt(" #n ")" ::: "memory")
#define PG8_BAR __builtin_amdgcn_s_barrier()
#define PG8_SCHED __builtin_amdgcn_sched_barrier(0)
    Unit cur, nxt; int ui = 0;
    if (!S.next(0, cur)) return;
    const float fz = opaque_zero();
    f32x4 acc[2][2][4][2];
#pragma unroll
    for (int a = 0; a < 2; ++a)
#pragma unroll
        for (int b = 0; b < 2; ++b)
#pragma unroll
            for (int m = 0; m < 4; ++m)
#pragma unroll
                for (int n = 0; n < 2; ++n) acc[a][b][m][n] = (f32x4){fz, fz, fz, fz};
    bf16x8 At[4][2], B0[2][2], B1[2][2];
    const char* cA = cur.a; const char* cB = cur.b;
    unsigned cP[2][2], nP[2][2];
    const char* gbase = nullptr; if constexpr (GATHER) gbase = S.gather_base();
    if constexpr (GATHER) S.rows(cur, cP);
    PG8_STAGE(PG8_SB(0, 0), cB); PG8_STAGE_A(PG8_SA(0, 0), cA, cP, 0, 0); PG8_STAGE(PG8_SB(0, 1), cB + hstep); PG8_STAGE_A(PG8_SA(0, 1), cA, cP, 1, 0);
    if (wr == 1) PG8_BAR;
    PG8_WAIT_V(4); PG8_BAR;
    PG8_STAGE(PG8_SB(1, 0), cB + kstep); PG8_STAGE_A(PG8_SA(1, 0), cA, cP, 0, kstep); PG8_STAGE(PG8_SB(1, 1), cB + hstep + kstep);
    PG8_WAIT_V(6); PG8_BAR;
    for (;;) {
        const bool has_next = S.next(ui + 1, nxt);
        const char* nA = has_next ? nxt.a : cA; const char* nB = has_next ? nxt.b : cB;
        if constexpr (GATHER) { if (has_next) S.rows(nxt, nP); else {
#pragma unroll
            for (int h = 0; h < 2; ++h)
#pragma unroll
                for (int i = 0; i < 2; ++i) nP[h][i] = cP[h][i]; } }
        for (int t = 0; t < nt; t += 2) {
            const bool last = (t == nt - 2);
            const size_t k1 = (size_t)(t + 1) * kstep;
            const char* a2 = last ? nA : cA; const char* b2 = last ? nB : cB + (size_t)(t + 2) * kstep;
            const size_t k2 = last ? 0 : (size_t)(t + 2) * kstep;
            const char* b3 = b2 + kstep;
            unsigned P2[2][2];
#pragma unroll
            for (int h = 0; h < 2; ++h)
#pragma unroll
                for (int i = 0; i < 2; ++i) P2[h][i] = last ? nP[h][i] : cP[h][i];
            PG8_LDB(B0, 0, 0); PG8_SCHED; PG8_LDA(At, 0, 0); PG8_STAGE_A(PG8_SA(1, 1), cA, cP, 1, k1);
            PG8_WAIT_L(8); PG8_BAR; PG8_WAIT_L(0); PG8_MMA(0, 0, At, B0); PG8_BAR; PG8_SCHED;
            PG8_LDB(B1, 0, 1); PG8_STAGE(PG8_SB(0, 0), b2);
            PG8_BAR; PG8_WAIT_L(0); PG8_MMA(0, 1, At, B1); PG8_BAR;
            PG8_LDA(At, 0, 1); PG8_STAGE_A(PG8_SA(0, 0), a2, P2, 0, k2);
            PG8_BAR; PG8_WAIT_L(0); PG8_MMA(1, 0, At, B0); PG8_BAR; PG8_SCHED;
            PG8_STAGE(PG8_SB(0, 1), b2 + hstep);
            PG8_WAIT_V(6); PG8_BAR; PG8_MMA(1, 1, At, B1); PG8_BAR;
            PG8_LDB(B0, 1, 0); PG8_SCHED; PG8_LDA(At, 1, 0); PG8_STAGE_A(PG8_SA(0, 1), a2, P2, 1, k2);
            PG8_WAIT_L(8); PG8_BAR; PG8_WAIT_L(0); PG8_MMA(0, 0, At, B0); PG8_BAR; PG8_SCHED;
            PG8_LDB(B1, 1, 1); PG8_STAGE(PG8_SB(1, 0), b3);
            PG8_BAR; PG8_WAIT_L(0); PG8_MMA(0, 1, At, B1); PG8_BAR;
            PG8_LDA(At, 1, 1); PG8_STAGE_A(PG8_SA(1, 0), a2, P2, 0, k2 + kstep);
            PG8_BAR; PG8_WAIT_L(0); PG8_MMA(1, 0, At, B0); PG8_BAR; PG8_SCHED;
            PG8_STAGE(PG8_SB(1, 1), b3 + hstep);
            PG8_WAIT_V(6); PG8_BAR; PG8_MMA(1, 1, At, B1); PG8_BAR;
        }
        E(acc, cur, wr, wc, fr, fq);
        if (!has_next) break;
#pragma unroll
        for (int a = 0; a < 2; ++a)
#pragma unroll
            for (int b = 0; b < 2; ++b)
#pragma unroll
                for (int m = 0; m < 4; ++m)
#pragma unroll
                    for (int n = 0; n < 2; ++n) acc[a][b][m][n] = (f32x4){fz, fz, fz, fz};
        cur = nxt; cA = nA; cB = nB; ++ui;
        if constexpr (GATHER) {
#pragma unroll
            for (int h = 0; h < 2; ++h)
#pragma unroll
                for (int i = 0; i < 2; ++i) cP[h][i] = nP[h][i];
        }
    }
    PG8_WAIT_V(0);
    if (wr == 0) PG8_BAR;
    PG8_BAR;
#undef PG8_SA
#undef PG8_SB
#undef PG8_STAGE
#undef PG8_STAGE_A
#undef PG8_LDA
#undef PG8_LDB
#undef PG8_MMA
#undef PG8_WAIT_V
#undef PG8_WAIT_L
#undef PG8_BAR
#undef PG8_SCHED
}
}

__device__ const double k_rope_consts[10] = {1.0, 0.19392274474868576, 0.03760603093086393, 0.007292664737217109, 0.001414213562373095,
                                             0.0002742481756762073, 5.318295896944988e-05, 1.031338537721246e-05, 6.283185307179586, 0.15915494309189535};
struct TJob { const float* W; bf16_t* WT; int K, ldw, n_src0, ncols, dst_row0, nb; size_t sstride, dstride; const float* kscale; int ileave; };
DEVFI void tj_load(const TJob& j, int it, int per, int nnb, int lane, f32x4 (&v)[8]) {
    const int b = it / per, r = it % per, kb = r / nnb, nb = r % nnb;
    const int nc = (j.ncols - nb * 32) < 32 ? (j.ncols - nb * 32) : 32;
    const float* src = j.W + (size_t)b * j.sstride + (size_t)(kb * 64 + (lane >> 3)) * j.ldw + j.n_src0 + nb * 32 + (lane & 7) * 4;
    const bool ok = (lane & 7) * 4 < nc;
#pragma unroll
    for (int i = 0; i < 8; ++i) v[i] = ok ? *(const f32x4*)(src + (size_t)(8 * i) * j.ldw) : (f32x4){0.f, 0.f, 0.f, 0.f};
}
DEVFI void tj_store(const TJob& j, int it, int per, int nnb, int lane, const f32x4 (&v)[8], float* scr) {
    const int b = it / per, r = it % per, kb = r / nnb, nb = r % nnb;
    const int nc = (j.ncols - nb * 32) < 32 ? (j.ncols - nb * 32) : 32;
    const int k0 = kb * 64;
#pragma unroll
    for (int i = 0; i < 8; ++i) {
        const int row = 8 * i + (lane >> 3);
        const float sc = j.kscale ? j.kscale[k0 + row] : 1.f;
        float* d = scr + row * 33 + (lane & 7) * 4;
        d[0] = v[i][0] * sc; d[1] = v[i][1] * sc; d[2] = v[i][2] * sc; d[3] = v[i][3] * sc;
    }
    asm volatile("s_waitcnt lgkmcnt(0)" ::: "memory");
    const int ch = lane & 7;
    bf16_t* WT = j.WT + (size_t)b * j.dstride;
#pragma unroll
    for (int q = 0; q < 4; ++q) {
        const int n = (lane >> 3) + 8 * q; const float* s = scr + (8 * ch) * 33 + n;
        uint4 o; o.x = pk2(s[0 * 33], s[1 * 33]); o.y = pk2(s[2 * 33], s[3 * 33]); o.z = pk2(s[4 * 33], s[5 * 33]); o.w = pk2(s[6 * 33], s[7 * 33]);
        const int jn = nb * 32 + n;
        const int drow = j.ileave ? ((jn >> 4) * 32 + (j.ileave - 1) * 16 + (jn & 15)) : jn;
        if (n < nc) *(uint4*)(WT + (size_t)(j.dst_row0 + drow) * j.K + k0 + 8 * ch) = o;
    }
    asm volatile("s_waitcnt lgkmcnt(0)" ::: "memory");
}
DEVFI void run_tjob(const TJob& j, float* scr, int gw, int ngw, int lane) {
    const int nkb = j.K / 64, nnb = (j.ncols + 31) / 32, per = nkb * nnb, total = per * j.nb;
    int it = gw;
    f32x4 cur[8];
    if (it < total) tj_load(j, it, per, nnb, lane, cur);
    while (it < total) {
        const int nx = it + ngw;
        f32x4 nxt[8];
        if (nx < total) tj_load(j, nx, per, nnb, lane, nxt);
        tj_store(j, it, per, nnb, lane, cur, scr);
#pragma unroll
        for (int i = 0; i < 8; ++i) cur[i] = nxt[i];
        it = nx;
    }
}

DEVFI void phase_prep(KP p, unsigned char* lds) {
    const int tid = opaque_tid(), lane = tid & 63, wid = tid >> 6;
    const int gw = blockIdx.x * 8 + wid, ngw = gridDim.x * 8;
    const int gt = blockIdx.x * 512 + tid, ngt = gridDim.x * 512;
    float* scr = (float*)(lds + wid * 8704);
    unsigned char* ws = p->ws;
    for (int l = 0; l < DEPTH; ++l) {
        const float* win = (const float*)p->in[4] + (size_t)l * 1024 * IN_COLS;
        bf16_t* wint = (bf16_t*)(ws + WS_WIN) + (size_t)l * ZN * 1024;
        TJob j;
        j.ileave = 0;
        j.nb = 1; j.sstride = 0; j.dstride = 0;
        j.kscale = (const float*)p->in[2] + (size_t)l * 1024;
        j.W = win; j.WT = wint; j.K = 1024; j.ldw = IN_COLS;
        j.n_src0 = 0; j.ncols = 1280; j.dst_row0 = 0; run_tjob(j, scr, gw, ngw, lane);
        j.n_src0 = SC_NG; j.ncols = 24; j.dst_row0 = ZC_NG; run_tjob(j, scr, gw, ngw, lane);
        j.n_src0 = SC_U; j.ncols = 256; j.dst_row0 = ZC_U; run_tjob(j, scr, gw, ngw, lane);
        j.n_src0 = SC_GA; j.ncols = 1024; j.dst_row0 = ZC_GA; run_tjob(j, scr, gw, ngw, lane);
        j.n_src0 = SC_GS; j.ncols = 1024; j.dst_row0 = ZC_GS; run_tjob(j, scr, gw, ngw, lane);
        { uint4* z = (uint4*)(wint + (size_t)IN_COLS * 1024); const int n16 = (ZN - IN_COLS) * 1024 * 2 / 16;
          const unsigned uz = __float_as_uint(opaque_zero());
          for (int i = gt; i < n16; i += ngt) z[i] = make_uint4(uz, uz, uz, uz); }
        j.kscale = nullptr;
        j.K = 2048; j.ldw = 128; j.n_src0 = 0; j.ncols = 128; j.dst_row0 = 0;
        j.W = (const float*)p->in[8] + (size_t)l * 2048 * 128; j.WT = (bf16_t*)(ws + WS_CW1) + (size_t)(l * 2 + 0) * 128 * 2048; run_tjob(j, scr, gw, ngw, lane);
        j.W = (const float*)p->in[11] + (size_t)l * 2048 * 128; j.WT = (bf16_t*)(ws + WS_CW1) + (size_t)(l * 2 + 1) * 128 * 2048; run_tjob(j, scr, gw, ngw, lane);
        j.K = 256; j.ldw = 512; j.ncols = 512; j.W = (const float*)p->in[21] + (size_t)l * 256 * 512; j.WT = (bf16_t*)(ws + WS_GLU) + (size_t)l * 512 * 256; run_tjob(j, scr, gw, ngw, lane);
        j.K = 512; j.ldw = 1024; j.ncols = 1024; j.W = (const float*)p->in[22] + (size_t)l * 512 * 1024; j.WT = (bf16_t*)(ws + WS_PA) + (size_t)l * 1024 * 512; run_tjob(j, scr, gw, ngw, lane);
        j.K = 256; j.ldw = 1024; j.ncols = 1024; j.W = (const float*)p->in[23] + (size_t)l * 256 * 1024; j.WT = (bf16_t*)(ws + WS_PS) + (size_t)l * 1024 * 256; run_tjob(j, scr, gw, ngw, lane);
        j.K = 1024; j.ldw = 1024; j.ncols = 1024; j.W = (const float*)p->in[24] + (size_t)l * 1024 * 1024; j.WT = (bf16_t*)(ws + WS_WO) + (size_t)l * 1024 * 1024; run_tjob(j, scr, gw, ngw, lane);
        j.nb = 32;
        j.kscale = (const float*)p->in[3] + (size_t)l * 1024;
        j.K = 1024; j.ldw = 512; j.ncols = 512; j.sstride = (size_t)1024 * 512; j.dstride = (size_t)1024 * 1024;
        j.ileave = 1; j.W = (const float*)p->in[29] + (size_t)l * 32 * 1024 * 512; j.WT = (bf16_t*)(ws + WS_EG) + (size_t)l * 32 * 1024 * 1024; run_tjob(j, scr, gw, ngw, lane);
        j.ileave = 2; j.W = (const float*)p->in[30] + (size_t)l * 32 * 1024 * 512; j.WT = (bf16_t*)(ws + WS_EG) + (size_t)l * 32 * 1024 * 1024; run_tjob(j, scr, gw, ngw, lane);
        j.ileave = 0;
        j.kscale = nullptr;
        j.K = 512; j.ldw = 1024; j.ncols = 1024; j.sstride = (size_t)512 * 1024; j.dstride = (size_t)1024 * 512;
        j.W = (const float*)p->in[31] + (size_t)l * 32 * 512 * 1024; j.WT = (bf16_t*)(ws + WS_ED) + (size_t)l * 32 * 1024 * 512; run_tjob(j, scr, gw, ngw, lane);
    }
    {
        const int* pos = (const int*)p->in[1]; float* rope = (float*)(ws + WS_ROPE);
        for (int i = gt; i < NTOK * 8; i += ngt) {
            const int n = i >> 3, f = i & 7;
            const double ang = (double)pos[n] * k_rope_consts[f];
            const double r = ang - k_rope_consts[8] * __builtin_rint(ang * k_rope_consts[9]);
            const float rf = (float)r;
            rope[n * 16 + f] = cosf(rf); rope[n * 16 + 8 + f] = sinf(rf);
        }
    }
    {
        float* LB = (float*)(ws + WS_S5LB); float* BB = (float*)(ws + WS_S5BB);
        const float* are = (const float*)p->in[13]; const float* aim = (const float*)p->in[14]; const float* ldt = (const float*)p->in[15];
        const float* bre = (const float*)p->in[16]; const float* bim = (const float*)p->in[17];
        for (int i = gt; i < DEPTH * 16 * 64; i += ngt) {
            const int lg = i >> 6;
            const float lre = fminf(are[i], -1e-4f), lim = aim[i];
            const float dt = expf(ldt[lg]);
            const float a = lre * dt, bq = lim * dt;
            const float em = expm1f(a), cb = cosf(bq), sb = sinf(bq), sh = sinf(0.5f * bq);
            const float lbr = (em + 1.f) * cb, lbi = (em + 1.f) * sb, lm1 = em * cb - 2.f * sh * sh;
            const float den = lre * lre + lim * lim;
            const float fr_ = (lm1 * lre + lbi * lim) / den, fi_ = (lbi * lre - lm1 * lim) / den;
            LB[i * 2] = lbr; LB[i * 2 + 1] = lbi;
            for (int c = 0; c < 16; ++c) {
                const float br = bre[(size_t)i * 16 + c], bi = bim[(size_t)i * 16 + c];
                BB[((size_t)i * 16 + c) * 2] = fr_ * br - fi_ * bi;
                BB[((size_t)i * 16 + c) * 2 + 1] = fr_ * bi + fi_ * br;
            }
        }
    }
    {
        float* POW = (float*)(ws + WS_POW);
        const float* are = (const float*)p->in[13]; const float* aim = (const float*)p->in[14]; const float* ldt = (const float*)p->in[15];
        for (int i = gt; i < DEPTH * 16 * 64 * 65; i += ngt) {
            const int n = i % 65, lgp = i / 65, lg = lgp >> 6;
            const float lre = fminf(are[lgp], -1e-4f), lim = aim[lgp];
            const float dt = expf(ldt[lg]);
            const float mag = expf((float)n * (lre * dt));
            const double ang = (double)n * ((double)lim * (double)dt);
            const float rf = (float)(ang - k_rope_consts[8] * __builtin_rint(ang * k_rope_consts[9]));
            POW[(size_t)i * 2] = mag * cosf(rf); POW[(size_t)i * 2 + 1] = mag * sinf(rf);
        }
    }
    for (int l = 0; l < DEPTH; ++l) {
        TJob j; j.ileave = 0; j.kscale = nullptr; j.nb = 1; j.sstride = 0; j.dstride = 0; j.K = 128; j.ldw = 64; j.n_src0 = 0; j.ncols = 64; j.dst_row0 = 0;
        j.W = (const float*)p->in[9] + (size_t)l * 128 * 64; j.WT = (bf16_t*)(ws + WS_CW2T) + (size_t)(l * 2 + 0) * 64 * 128; run_tjob(j, scr, gw, ngw, lane);
        j.W = (const float*)p->in[12] + (size_t)l * 128 * 64; j.WT = (bf16_t*)(ws + WS_CW2T) + (size_t)(l * 2 + 1) * 64 * 128; run_tjob(j, scr, gw, ngw, lane);
    }
    {
        float* WRT = (float*)(ws + WS_WRT);
        for (int i = gt; i < DEPTH * 48 * 1024; i += ngt) {
            const int k = i & 1023, jn = (i >> 10) % 48, l = (i >> 10) / 48;
            const float gn = ((const float*)p->in[3])[l * 1024 + k];
            float w = 0.f;
            if (jn < 4) w = ((const float*)p->in[25])[((size_t)l * 1024 + k) * 4 + jn];
            else if (jn < 36) w = ((const float*)p->in[27])[((size_t)l * 1024 + k) * 32 + (jn - 4)];
            WRT[i] = gn * w;
        }
    }
    {
        float* CB = (float*)(ws + WS_CB1);
        for (int o = gw; o < DEPTH * 2 * 128; o += ngw) {
            const int l = o >> 8, kv = (o >> 7) & 1, jn = o & 127;
            const float* pe = (const float*)p->in[kv ? 10 : 7] + (size_t)l * 2048;
            const float* w1 = (const float*)p->in[kv ? 11 : 8] + (size_t)l * 2048 * 128;
            float s = 0.f;
            for (int k = lane; k < 2048; k += 64) s += pe[k] * w1[(size_t)k * 128 + jn];
            s = wave_sum(s);
            if (lane == 0) CB[o] = s;
        }
    }
}


DEVFI void phase_prep1(KP p) {
    const int tid = opaque_tid();
    const int gt = blockIdx.x * 512 + tid, ngt = gridDim.x * 512;
    unsigned char* ws = p->ws;
    const float* POW = (const float*)(ws + WS_POW); const float* BB = (const float*)(ws + WS_S5BB);
    const float* cre = (const float*)p->in[18]; const float* cim = (const float*)p->in[19];
    bf16_t* KT = (bf16_t*)(ws + WS_KTAB); bf16_t* MS = (bf16_t*)(ws + WS_MSTATE); bf16_t* MC = (bf16_t*)(ws + WS_MCARRY);
    for (int i = gt; i < DEPTH * 16 * 66 * 256; i += ngt) {
        const int cc = i & 15, c = (i >> 4) & 15, row = (i >> 8) % 66, lg = (i >> 8) / 66;
        float acc = 0.f;
        if (row >= 1 && row <= 64) {
            const int tau = row - 1;
            const float* pw = POW + ((size_t)(lg * 64) * 65 + tau) * 2;
            const float* bb = BB + ((size_t)(lg * 64) * 16 + cc) * 2;
            const float* cr_ = cre + ((size_t)lg * 16 + c) * 64; const float* ci_ = cim + ((size_t)lg * 16 + c) * 64;
            for (int p8 = 0; p8 < 64; p8 += 8) {
                float wr[8], wi[8], br[8], bi[8], cr[8], ci[8];
#pragma unroll
                for (int e = 0; e < 8; ++e) {
                    const int pq = p8 + e;
                    wr[e] = pw[(size_t)pq * 130]; wi[e] = pw[(size_t)pq * 130 + 1];
                    br[e] = bb[(size_t)pq * 32]; bi[e] = bb[(size_t)pq * 32 + 1];
                    cr[e] = cr_[pq]; ci[e] = ci_[pq];
                }
#pragma unroll
                for (int e = 0; e < 8; ++e) { const float tr = wr[e] * br[e] - wi[e] * bi[e], ti = wr[e] * bi[e] + wi[e] * br[e]; acc += cr[e] * tr - ci[e] * ti; }
            }
        }
        KT[i] = (bf16_t)f2bf(acc);
    }
    for (int i = gt; i < DEPTH * 16 * 128 * 128; i += ngt) {
        const int half = i & 1, sidx = (i >> 1) & 63, pp = (i >> 7) & 127, lg = i >> 14;
        const int pq = pp & 63;
        const float wr = POW[((size_t)(lg * 64 + pq) * 65 + (63 - sidx)) * 2], wi = POW[((size_t)(lg * 64 + pq) * 65 + (63 - sidx)) * 2 + 1];
        const f32x4* bp = (const f32x4*)(BB + ((size_t)(lg * 64 + pq) * 16 + half * 8) * 2);
        const f32x4 b0 = bp[0], b1 = bp[1], b2 = bp[2], b3 = bp[3];
        float o[8];
        if (pp < 64) { o[0] = wr * b0[0] - wi * b0[1]; o[1] = wr * b0[2] - wi * b0[3]; o[2] = wr * b1[0] - wi * b1[1]; o[3] = wr * b1[2] - wi * b1[3];
                       o[4] = wr * b2[0] - wi * b2[1]; o[5] = wr * b2[2] - wi * b2[3]; o[6] = wr * b3[0] - wi * b3[1]; o[7] = wr * b3[2] - wi * b3[3]; }
        else         { o[0] = wr * b0[1] + wi * b0[0]; o[1] = wr * b0[3] + wi * b0[2]; o[2] = wr * b1[1] + wi * b1[0]; o[3] = wr * b1[3] + wi * b1[2];
                       o[4] = wr * b2[1] + wi * b2[0]; o[5] = wr * b2[3] + wi * b2[2]; o[6] = wr * b3[1] + wi * b3[0]; o[7] = wr * b3[3] + wi * b3[2]; }
        uint4 w; w.x = pk2(o[0], o[1]); w.y = pk2(o[2], o[3]); w.z = pk2(o[4], o[5]); w.w = pk2(o[6], o[7]);
        *(uint4*)(MS + ((size_t)(lg * 128 + pp) * 1024 + sidx * 16 + half * 8)) = w;
    }
    for (int i = gt; i < DEPTH * 16 * 1024 * 16; i += ngt) {
        const int p8 = i & 15, n = (i >> 4) & 1023, lg = i >> 14;
        const int t = n >> 4, c = n & 15, pq0 = (p8 & 7) * 8;
        const bool isre = p8 < 8;
        const f32x4* crp = (const f32x4*)(cre + ((size_t)lg * 16 + c) * 64 + pq0); const f32x4* cip = (const f32x4*)(cim + ((size_t)lg * 16 + c) * 64 + pq0);
        const f32x4 cr0 = crp[0], cr1 = crp[1], ci0 = cip[0], ci1 = cip[1];
        float o[8];
#pragma unroll
        for (int e = 0; e < 8; ++e) {
            const float wr = POW[((size_t)(lg * 64 + pq0 + e) * 65 + (t + 1)) * 2], wi = POW[((size_t)(lg * 64 + pq0 + e) * 65 + (t + 1)) * 2 + 1];
            const float cr = e < 4 ? cr0[e & 3] : cr1[e & 3], ci = e < 4 ? ci0[e & 3] : ci1[e & 3];
            o[e] = isre ? cr * wr - ci * wi : -(cr * wi + ci * wr);
        }
        uint4 w; w.x = pk2(o[0], o[1]); w.y = pk2(o[2], o[3]); w.z = pk2(o[4], o[5]); w.w = pk2(o[6], o[7]);
        *(uint4*)(MC + ((size_t)(lg * 1024 + n) * 128 + p8 * 8)) = w;
    }
}

DEVFI int seg_start_lane(const int* cnt, int lane) {
    const int c = (lane < 32) ? cnt[lane] : 0;
    const int pad = (c + 255) & ~255;
    int incl = pad;
#pragma unroll
    for (int o = 1; o < 32; o <<= 1) { const int v = __builtin_amdgcn_ds_bpermute((lane - o) << 2, incl); if ((lane & 31) >= o) incl += v; }
    return incl - pad;
}

DEVFI void stage_norm1(KP p, int l, bool final_only) {
    const int tid = opaque_tid(), lane = tid & 63, wid = tid >> 6;
    const int gw = blockIdx.x * 8 + wid, ngw = gridDim.x * 8;
    unsigned char* ws = p->ws;
    const float* xin = (const float*)p->in[0];
    float* xres = p->out;
    bf16_t* XB = (bf16_t*)(ws + WS_H);
    float* RS = (float*)(ws + WS_RSTD);
    const bf16_t* Y = (const bf16_t*)(ws + WS_Y);
    const int* eid = (const int*)(ws + WS_EID); const float* ew = (const float*)(ws + WS_EW); const int* epos = (const int*)(ws + WS_EPOS);
    int segs = 0;
    if (l > 0) segs = seg_start_lane((const int*)(ws + CTL_CNT) + (l - 1) * 32, lane);
    for (int row0 = gw * 2; row0 < NTOK; row0 += ngw * 2) {
        f32x4 v[2][4];
        if (l == 0) {
#pragma unroll
            for (int q = 0; q < 2; ++q)
#pragma unroll
                for (int j = 0; j < 4; ++j) v[q][j] = *(const f32x4*)(xin + (size_t)(row0 + q) * 1024 + lane * 4 + 256 * j);
        } else {
            uint2 ya[2][4], yb[2][4]; float w0[2], w1[2];
#pragma unroll
            for (int q = 0; q < 2; ++q) {
                const int row = row0 + q;
                const int e0 = eid[row * 2], e1 = eid[row * 2 + 1];
                w0[q] = ew[row * 2]; w1[q] = ew[row * 2 + 1];
                const int s0 = __builtin_amdgcn_ds_bpermute(e0 << 2, segs) + epos[row * 2], s1 = __builtin_amdgcn_ds_bpermute(e1 << 2, segs) + epos[row * 2 + 1];
#pragma unroll
                for (int j = 0; j < 4; ++j) {
                    v[q][j] = *(const f32x4*)(xres + (size_t)row * 1024 + lane * 4 + 256 * j);
                    ya[q][j] = *(const uint2*)(Y + (size_t)s0 * 1024 + lane * 4 + 256 * j);
                    yb[q][j] = *(const uint2*)(Y + (size_t)s1 * 1024 + lane * 4 + 256 * j);
                }
            }
#pragma unroll
            for (int q = 0; q < 2; ++q)
#pragma unroll
                for (int j = 0; j < 4; ++j) {
                    const uint2 a = ya[q][j], bq = yb[q][j];
                    v[q][j][0] += w0[q] * __uint_as_float(a.x << 16) + w1[q] * __uint_as_float(bq.x << 16);
                    v[q][j][1] += w0[q] * __uint_as_float(a.x & 0xffff0000u) + w1[q] * __uint_as_float(bq.x & 0xffff0000u);
                    v[q][j][2] += w0[q] * __uint_as_float(a.y << 16) + w1[q] * __uint_as_float(bq.y << 16);
                    v[q][j][3] += w0[q] * __uint_as_float(a.y & 0xffff0000u) + w1[q] * __uint_as_float(bq.y & 0xffff0000u);
                }
        }
#pragma unroll
        for (int q = 0; q < 2; ++q) {
            const int row = row0 + q;
#pragma unroll
            for (int j = 0; j < 4; ++j) *(f32x4*)(xres + (size_t)row * 1024 + lane * 4 + 256 * j) = v[q][j];
            if (final_only) continue;
            float ss = 0.f;
#pragma unroll
            for (int j = 0; j < 4; ++j) ss += v[q][j][0] * v[q][j][0] + v[q][j][1] * v[q][j][1] + v[q][j][2] * v[q][j][2] + v[q][j][3] * v[q][j][3];
            ss = wave_sum(ss);
            if (lane == 0) RS[row] = rsqrtf(ss * (1.f / 1024.f) + RMS_EPS);
#pragma unroll
            for (int j = 0; j < 4; ++j) {
                uint2 o; o.x = pk2(v[q][j][0], v[q][j][1]); o.y = pk2(v[q][j][2], v[q][j][3]);
                *(uint2*)(XB + (size_t)row * 1024 + lane * 4 + 256 * j) = o;
            }
        }
    }
}

DEVFI void xcd_order(int L, int nM, int nN, int& pm, int& pn) {
    const int nwg = nM * nN;
    int wgid = L; { const int q = nwg / 8, r = nwg % 8, xcd = wgid % 8, off = wgid / 8; wgid = (xcd < r ? xcd * (q + 1) : r * (q + 1) + (xcd - r) * q) + off; }
    const int nig = 8 * nN, gid = wgid / nig, fm = gid * 8, gsz = (nM - fm) < 8 ? (nM - fm) : 8;
    pm = fm + ((wgid % nig) % gsz); pn = (wgid % nig) / gsz;
}
struct GP4 { const bf16_t *a0, *a1, *b0, *b1; };
struct InprojSched {
    const char* A; const char* B; int G, c;
    DEVFI bool next(int i, pg8::Unit& u) const {
        constexpr int NMT = NTOK / 256, NNT = ZN / 256;
        const int v = c + i * G; if (v >= NMT * NNT) return false;
        int mt, nt; xcd_order(v, NMT, NNT, mt, nt);
        u.a = A + (size_t)mt * 256 * 1024 * 2; u.b = B + (size_t)nt * 256 * 1024 * 2; u.r0 = mt * 256; u.c0 = nt * 256; u.x0 = 0; u.x1 = 0;
        return true;
    }
};
struct InprojEpi {
    bf16_t* Z; const float* RS;
    DEVFI void operator()(const f32x4 (&acc)[2][2][4][2], const pg8::Unit& u, int wr, int wc, int fr, int fq) const {
#pragma unroll
        for (int ai = 0; ai < 2; ++ai)
#pragma unroll
            for (int m = 0; m < 4; ++m) {
                const int row = u.r0 + ai * 128 + wr * 64 + m * 16 + fr;
                const float rs = RS[row];
                bf16_t* zp = Z + (size_t)row * ZN + u.c0 + wc * 32 + fq * 4;
#pragma unroll
                for (int bj = 0; bj < 2; ++bj)
#pragma unroll
                    for (int n = 0; n < 2; ++n) {
                        const f32x4 v = acc[ai][bj][m][n] * rs;
                        uint2 o; o.x = pk2(v[0], v[1]); o.y = pk2(v[2], v[3]);
                        *(uint2*)(zp + bj * 128 + n * 16) = o;
                    }
            }
    }
};
DEVFI void stage_inproj(KP p, int l, unsigned char* lds) {
    unsigned char* ws = p->ws;
    InprojSched S{(const char*)(ws + WS_H), (const char*)(ws + WS_WIN) + (size_t)l * ZN * 1024 * 2, (int)gridDim.x, (int)blockIdx.x};
    InprojEpi E{(bf16_t*)(ws + WS_Z), (const float*)(ws + WS_RSTD)};
    pg8::gemm_phase(lds, 1024, S, E);
}

DEVFI void s5_unit(KP p, int l, int b, int g, unsigned char* lds, const int tid) {
    const int lane = tid & 63, wid = tid >> 6, fr = lane & 15, fq = lane >> 4;
    unsigned char* ws = p->ws;
    const bf16_t* Z = (const bf16_t*)(ws + WS_Z);
    const int lg = l * 16 + g;
    const bf16_t* KT = (const bf16_t*)(ws + WS_KTAB) + (size_t)lg * 66 * 256;
    const bf16_t* MS = (const bf16_t*)(ws + WS_MSTATE) + (size_t)lg * 128 * 1024;
    const bf16_t* MC = (const bf16_t*)(ws + WS_MCARRY) + (size_t)lg * 1024 * 128;
    unsigned char* ul = lds;
    unsigned char* kl = lds + 65536;
    float* sl = (float*)(lds + 100352);
    unsigned char* xl = lds + 116736;
    {
        const int chunk = (tid >> 2) & 31, slot = tid & 3;
#pragma unroll
        for (int i = 0; i < 8; ++i) {
            const int pan = i * 4 + (tid >> 7), sidx = 2 * pan + (slot >> 1);
            glds16(Z + (size_t)(b * SEQ + chunk * 64 + sidx) * ZN + ZC_U + g * 16 + (slot & 1) * 8, ul + i * 8192 + tid * 16);
        }
#pragma unroll
        for (int i = 0; i < 4; ++i) glds16(KT + (size_t)(i * 512 + tid) * 8, kl + i * 8192 + tid * 16);
        if (wid == 0) glds16(KT + (size_t)(2048 + tid) * 8, kl + 32768 + tid * 16);
    }
    asm volatile("s_waitcnt vmcnt(0)" ::: "memory");
    __syncthreads();
    {
        f32x4 acc[2] = {{0.f, 0.f, 0.f, 0.f}, {0.f, 0.f, 0.f, 0.f}};
        const bf16_t* bp = MS + (size_t)(wid * 16 + fr) * 1024 + fq * 8;
#pragma unroll 4
        for (int kk = 0; kk < 32; ++kk) {
            const bf16x8 bfv = *(const bf16x8*)(bp + kk * 32);
#pragma unroll
            for (int mt = 0; mt < 2; ++mt) {
                const bf16x8 af = *(const bf16x8*)(ul + kk * 2048 + (mt * 16 + fr) * 64 + fq * 16);
                acc[mt] = __builtin_amdgcn_mfma_f32_16x16x32_bf16(bfv, af, acc[mt], 0, 0, 0);
            }
        }
#pragma unroll
        for (int mt = 0; mt < 2; ++mt) *(f32x4*)(sl + (mt * 16 + fr) * 128 + wid * 16 + fq * 4) = acc[mt];
    }
    __syncthreads();
    if (wid == 0) {
        const float* POW = (const float*)(ws + WS_POW);
        const float tr = POW[((size_t)(lg * 64 + lane) * 65 + 64) * 2], ti = POW[((size_t)(lg * 64 + lane) * 65 + 64) * 2 + 1];
        float xr = 0.f, xi = 0.f;
        for (int k = 0; k < 32; ++k) {
            *(bf16_t*)(xl + (lane >> 5) * 2048 + k * 64 + (lane & 31) * 2) = (bf16_t)f2bf(xr);
            *(bf16_t*)(xl + (2 + (lane >> 5)) * 2048 + k * 64 + (lane & 31) * 2) = (bf16_t)f2bf(xi);
            const float sr = sl[k * 128 + lane], si = sl[k * 128 + 64 + lane];
            const float nr = tr * xr - ti * xi + sr, ni = tr * xi + ti * xr + si;
            xr = nr; xi = ni;
        }
    }
    __syncthreads();
    {
        const float* dsk = (const float*)p->in[20] + l * 256 + g * 16;
        const f32x4 dv = *(const f32x4*)(dsk + fq * 4);
        bf16_t* YB = (bf16_t*)(ws + WS_YB);
#pragma unroll 1
        for (int i = 0; i < 8; ++i) {
            const int t = wid + 8 * i;
            f32x4 acc[2] = {{0.f, 0.f, 0.f, 0.f}, {0.f, 0.f, 0.f, 0.f}};
            const int nk = (t >> 1) + 1;
            for (int kk = 0; kk < nk; ++kk) {
                const int srow = t - (2 * kk + (fq >> 1)) + 1;
                const bf16x8 bfv = *(const bf16x8*)(kl + srow * 512 + fr * 32 + (fq & 1) * 16);
#pragma unroll
                for (int mt = 0; mt < 2; ++mt) {
                    const bf16x8 af = *(const bf16x8*)(ul + kk * 2048 + (mt * 16 + fr) * 64 + fq * 16);
                    acc[mt] = __builtin_amdgcn_mfma_f32_16x16x32_bf16(bfv, af, acc[mt], 0, 0, 0);
                }
            }
            const bf16_t* cp = MC + (size_t)(t * 16 + fr) * 128 + fq * 8;
#pragma unroll
            for (int kk = 0; kk < 4; ++kk) {
                const bf16x8 bfv = *(const bf16x8*)(cp + kk * 32);
#pragma unroll
                for (int mt = 0; mt < 2; ++mt) {
                    const bf16x8 af = *(const bf16x8*)(xl + kk * 2048 + (mt * 16 + fr) * 64 + fq * 16);
                    acc[mt] = __builtin_amdgcn_mfma_f32_16x16x32_bf16(bfv, af, acc[mt], 0, 0, 0);
                }
            }
#pragma unroll
            for (int mt = 0; mt < 2; ++mt) {
                const size_t n = (size_t)b * SEQ + (mt * 16 + fr) * 64 + t;
                const uint2 uu = *(const uint2*)(Z + n * ZN + ZC_U + g * 16 + fq * 4);
                const float u0 = __uint_as_float(uu.x << 16), u1 = __uint_as_float(uu.x & 0xffff0000u), u2 = __uint_as_float(uu.y << 16), u3 = __uint_as_float(uu.y & 0xffff0000u);
                uint2 w;
                w.x = pk2(gelu_tanh(acc[mt][0] + dv[0] * u0), gelu_tanh(acc[mt][1] + dv[1] * u1));
                w.y = pk2(gelu_tanh(acc[mt][2] + dv[2] * u2), gelu_tanh(acc[mt][3] + dv[3] * u3));
                *(uint2*)(YB + n * 256 + g * 16 + fq * 4) = w;
            }
        }
    }
    __syncthreads();
}

DEVFI void cmp_unit(KP p, int l, int u, unsigned char* lds, const int tid) {
    const int lane = tid & 63, wid = tid >> 6, wr = wid >> 1, wc = wid & 1, fr = lane & 15, fq = lane >> 4;
    unsigned char* ws = p->ws;
    const bf16_t* Z = (const bf16_t*)(ws + WS_Z);
    const bf16_t* W1 = (const bf16_t*)(ws + WS_CW1) + (size_t)l * 2 * 128 * 2048;
    const float* CB = (const float*)(ws + WS_CB1) + l * 256;
    constexpr int MR = BATCH * 2 * NCMP;
    const int kv = u >> 3, mt = u & 7;
    auto rowptr = [&](int r) -> const bf16_t* {
        if (r >= MR) r = MR - 1;
        const int bh = r / NCMP, c = r % NCMP, b = bh >> 1, hk = bh & 1;
        return Z + (size_t)(b * SEQ + 16 * c) * ZN + (kv ? ZC_VC : ZC_KC) + hk * 64;
    };
    const bf16_t* a0 = rowptr(mt * 256 + (tid >> 2)) + SWZ_CHUNK(tid);
    const bf16_t* a1 = rowptr(mt * 256 + 128 + (tid >> 2)) + SWZ_CHUNK(tid);
    const bf16_t* b0 = W1 + (size_t)kv * 128 * 2048 + (size_t)(tid >> 2) * 2048 + SWZ_CHUNK(tid);
    f32x4 acc[1][4][4];
    gemm_tile<1>(lds, a0, a1, ZN, b0, nullptr, 32, acc);
#pragma unroll
    for (int m = 0; m < 4; ++m)
#pragma unroll
        for (int n = 0; n < 4; ++n) {
            const int row = wr * 64 + m * 16 + fr, col = wc * 64 + n * 16 + fq * 4;
            float o[4];
#pragma unroll
            for (int r = 0; r < 4; ++r) o[r] = gelu_tanh(acc[0][m][n][r] + CB[kv * 128 + col + r]);
            uint2 w; w.x = pk2(o[0], o[1]); w.y = pk2(o[2], o[3]);
            *(uint2*)(lds + (col >> 5) * 16384 + row * 64 + (col & 31) * 2) = w;
        }
    __syncthreads();
    const bf16_t* W2 = (const bf16_t*)(ws + WS_CW2T) + (size_t)(l * 2 + kv) * 64 * 128;
    f32x4 o2[2][4];
#pragma unroll
    for (int m = 0; m < 2; ++m)
#pragma unroll
        for (int n = 0; n < 4; ++n) o2[m][n] = (f32x4){0.f, 0.f, 0.f, 0.f};
#pragma unroll
    for (int kk = 0; kk < 4; ++kk) {
        bf16x8 af[2], bfv[4];
#pragma unroll
        for (int m = 0; m < 2; ++m) af[m] = *(const bf16x8*)(lds + kk * 16384 + (wid * 32 + m * 16 + fr) * 64 + fq * 16);
#pragma unroll
        for (int n = 0; n < 4; ++n) bfv[n] = *(const bf16x8*)(W2 + (size_t)(n * 16 + fr) * 128 + kk * 32 + fq * 8);
#pragma unroll
        for (int m = 0; m < 2; ++m)
#pragma unroll
            for (int n = 0; n < 4; ++n) o2[m][n] = __builtin_amdgcn_mfma_f32_16x16x32_bf16(bfv[n], af[m], o2[m][n], 0, 0, 0);
    }
    const float* rope = (const float*)(ws + WS_ROPE);
    const float* kg = (const float*)p->in[6] + l * 64;
#pragma unroll
    for (int m = 0; m < 2; ++m) {
        const int row = mt * 256 + wid * 32 + m * 16 + fr;
        const int rr = row < MR ? row : MR - 1;
        const int bh = rr / NCMP, c = rr % NCMP, b = bh >> 1;
        if (kv == 0) {
            float ss = 0.f;
#pragma unroll
            for (int n = 0; n < 4; ++n) ss += o2[m][n][0] * o2[m][n][0] + o2[m][n][1] * o2[m][n][1] + o2[m][n][2] * o2[m][n][2] + o2[m][n][3] * o2[m][n][3];
            ss += xshfl(ss, 16); ss += xshfl(ss, 32);
            const float rstd = rsqrtf(ss * (1.f / 64.f) + RMS_EPS);
#pragma unroll
            for (int n = 0; n < 4; ++n) { const f32x4 gv = *(const f32x4*)(kg + n * 16 + fq * 4); o2[m][n] = o2[m][n] * rstd * gv; }
            const int tokn = b * SEQ + 16 * c + 31;
            const f32x4 cs = *(const f32x4*)(rope + (size_t)tokn * 16 + (fq & 1) * 4), sn = *(const f32x4*)(rope + (size_t)tokn * 16 + 8 + (fq & 1) * 4);
            f32x4 oth;
#pragma unroll
            for (int r = 0; r < 4; ++r) oth[r] = xshfl(o2[m][0][r], 32);
            o2[m][0] = fq < 2 ? o2[m][0] * cs - oth * sn : o2[m][0] * cs + oth * sn;
        }
        if (row < MR) {
            bf16_t* dst = (bf16_t*)(ws + (kv ? WS_VCB : WS_KCB)) + ((size_t)bh * 128 + c) * 64 + fq * 4;
#pragma unroll
            for (int n = 0; n < 4; ++n) {
                uint2 w; w.x = pk2(o2[m][n][0], o2[m][n][1]); w.y = pk2(o2[m][n][2], o2[m][n][3]);
                *(uint2*)(dst + n * 16) = w;
                if (c == 0) *(uint2*)(dst + 127 * 64 + n * 16) = make_uint2(0u, 0u);
            }
        }
    }
    __syncthreads();
}

DEVFI void stage_posta(KP p, int l, unsigned char* lds) {
    const int tid = opaque_tid();
    const int gt = blockIdx.x * 512 + tid, ngt = gridDim.x * 512;
    unsigned char* ws = p->ws;
    for (int u = blockIdx.x; u < BATCH * 16 + 16; u += gridDim.x) {
        if (u < BATCH * 16) s5_unit(p, l, u >> 4, u & 15, lds, tid);
        else cmp_unit(p, l, u - BATCH * 16, lds, tid);
    }
    {
        bf16_t* Z = (bf16_t*)(ws + WS_Z);
        const float* rope = (const float*)(ws + WS_ROPE);
        const float* qg = (const float*)p->in[5] + l * 64; const float* kg = (const float*)p->in[6] + l * 64;
        for (int i = gt; i < NTOK * 12; i += ngt) {
            const int n = i / 12, hs = i % 12;
            const int col = hs < 8 ? ZC_Q + hs * 64 : (hs < 10 ? ZC_KS + (hs - 8) * 64 : ZC_KW + (hs - 10) * 64);
            const float* gn = hs < 8 ? qg : kg;
            bf16_t* zp = Z + (size_t)n * ZN + col;
            float v[64];
#pragma unroll
            for (int j = 0; j < 8; ++j) unpack8(*(const uint4*)(zp + j * 8), v + j * 8);
            float ss = 0.f;
#pragma unroll
            for (int j = 0; j < 64; ++j) ss += v[j] * v[j];
            const float rstd = rsqrtf(ss * (1.f / 64.f) + RMS_EPS);
            const float rq = rstd * (hs < 8 ? 0.125f * 1.4426950408889634f : 1.f);
#pragma unroll
            for (int j = 0; j < 64; ++j) v[j] = v[j] * rq * gn[j];
#pragma unroll
            for (int f = 0; f < 8; ++f) {
                const float c = rope[n * 16 + f], sn = rope[n * 16 + 8 + f];
                const float x1 = v[f], x2 = v[8 + f];
                v[f] = x1 * c - x2 * sn; v[8 + f] = x2 * c + x1 * sn;
            }
#pragma unroll
            for (int j = 0; j < 8; ++j) {
                uint4 o; o.x = pk2(v[j * 8], v[j * 8 + 1]); o.y = pk2(v[j * 8 + 2], v[j * 8 + 3]); o.z = pk2(v[j * 8 + 4], v[j * 8 + 5]); o.w = pk2(v[j * 8 + 6], v[j * 8 + 7]);
                *(uint4*)(zp + j * 8) = o;
            }
        }
    }
}

DEVFI bf16x8 pack8(const f32x16& v, const int o) {
    const unsigned a = pk2(v[o], v[o + 1]), b = pk2(v[o + 2], v[o + 3]), c = pk2(v[o + 4], v[o + 5]), d = pk2(v[o + 6], v[o + 7]);
    typedef unsigned u32x4 __attribute__((ext_vector_type(4)));
    const u32x4 w = {a, b, c, d};
    return __builtin_bit_cast(bf16x8, w);
}
DEVFI bf16x8 tr_read2(const unsigned char* p) {
    LAS s16x4* q = (LAS s16x4*)(LAS unsigned char*)p;
    const s16x4 a = __builtin_amdgcn_ds_read_tr16_b64_v4i16(q);
    const s16x4 b = __builtin_amdgcn_ds_read_tr16_b64_v4i16(q + 64);
    return (bf16x8){a[0], a[1], a[2], a[3], b[0], b[1], b[2], b[3]};
}
typedef unsigned long long u64_t;
#define TR8(base, OFF, f) do { u64_t _a0, _a1, _a2, _a3, _a4, _a5, _a6, _a7; \
    asm volatile("ds_read_b64_tr_b16 %0, %8 offset:%9\n\tds_read_b64_tr_b16 %1, %8 offset:%10\n\tds_read_b64_tr_b16 %2, %8 offset:%11\n\tds_read_b64_tr_b16 %3, %8 offset:%12\n\t" \
                 "ds_read_b64_tr_b16 %4, %8 offset:%13\n\tds_read_b64_tr_b16 %5, %8 offset:%14\n\tds_read_b64_tr_b16 %6, %8 offset:%15\n\tds_read_b64_tr_b16 %7, %8 offset:%16\n\ts_waitcnt lgkmcnt(0)" \
        : "=&v"(_a0), "=&v"(_a1), "=&v"(_a2), "=&v"(_a3), "=&v"(_a4), "=&v"(_a5), "=&v"(_a6), "=&v"(_a7) \
        : "v"(base), "i"((OFF)), "i"((OFF) + 512), "i"((OFF) + 4096), "i"((OFF) + 4096 + 512), "i"((OFF) + 1024), "i"((OFF) + 1024 + 512), "i"((OFF) + 4096 + 1024), "i"((OFF) + 4096 + 1024 + 512)); \
    typedef u64_t u64x2_ __attribute__((ext_vector_type(2))); \
    f[0][0] = __builtin_bit_cast(bf16x8, (u64x2_){_a0, _a1}); f[1][0] = __builtin_bit_cast(bf16x8, (u64x2_){_a2, _a3}); \
    f[0][1] = __builtin_bit_cast(bf16x8, (u64x2_){_a4, _a5}); f[1][1] = __builtin_bit_cast(bf16x8, (u64x2_){_a6, _a7}); } while (0)
#define KK(reg) (((reg) & 3) + 8 * ((reg) >> 2))
DEVFI void stage_attn(KP p, int l, unsigned char* lds) {
    const int tid = opaque_tid(), lane = tid & 63, wid = tid >> 6, r = lane & 31, h = lane >> 5;
    unsigned char* ws = p->ws;
    const bf16_t* Z = (const bf16_t*)(ws + WS_Z);
    const bf16_t* KCb = (const bf16_t*)(ws + WS_KCB); const bf16_t* VCb = (const bf16_t*)(ws + WS_VCB);
    bf16_t* OA = (bf16_t*)(ws + WS_OA);
    float kbound;
    { const float* kg = (const float*)p->in[6] + l * 64; float gm = fabsf(kg[lane]);
#pragma unroll
      for (int o = 1; o < 64; o <<= 1) gm = fmaxf(gm, xshfl(gm, o));
      kbound = 8.1f * gm; }
    unsigned char* ring = lds; unsigned char* kcl = lds + 65536; unsigned char* vcl = lds + 81920;
    const int xsw = (r >> 2) & 3;
    const int ksl0 = ((0 + h) ^ xsw) * 16, ksl1 = ((2 + h) ^ xsw) * 16;
    const int vlo = (4 * h + ((r & 15) >> 2)) * 64 + ((r >> 4) * 16 + 4 * (r & 3)) * 2;
    const float fz = opaque_zero();
#define ZERO16_LIT ((f32x16){0.f, 0.f, 0.f, 0.f, 0.f, 0.f, 0.f, 0.f, 0.f, 0.f, 0.f, 0.f, 0.f, 0.f, 0.f, 0.f})
#define ZERO16_FZ ((f32x16){fz, fz, fz, fz, fz, fz, fz, fz, fz, fz, fz, fz, fz, fz, fz, fz})
    for (int pair = blockIdx.x; pair < 256; pair += gridDim.x) {
        const int bh = pair >> 4, ap = pair & 15, b = bh >> 1, hk = bh & 1;
#pragma unroll 1
        for (int ui = 0; ui < 2; ++ui) {
            const int a = ui == 0 ? 31 - ap : ap;
            const int t0 = 64 * a;
            const int tok = t0 + 8 * wid + (r >> 2), g = r & 3, hq = hk * 4 + g;
            const bf16_t* zrow = Z + (size_t)(b * SEQ + tok) * ZN;
            constexpr int NSUB = 1;
            const int jw0 = a > 8 ? a - 8 : 0, nslc = (a + NSUB) / NSUB, nsteps = nslc + (a - jw0 + NSUB) / NSUB;
            auto stage_kv = [&](int st, int buf) {
                const int tid = opaque_tid();
                const int s_pan = tid >> 8, s_key = (tid >> 2) & 63, s_cs = tid & 3, s_kc = s_cs ^ ((s_key >> 2) & 3);
                const bool slc = st < nslc; const int jb = slc ? NSUB * st : jw0 + NSUB * (st - nslc);
#pragma unroll
                for (int sub = 0; sub < NSUB; ++sub) {
                    const int j = jb + sub <= a ? jb + sub : a;
                    const bf16_t* src = Z + (size_t)(b * SEQ + 64 * j + s_key) * ZN + hk * 64 + s_pan * 32;
                    glds16(src + (slc ? ZC_KS : ZC_KW) + s_kc * 8, ring + buf * (NSUB * 16384) + sub * 16384 + tid * 16);
                    glds16(src + (slc ? ZC_VS : ZC_VW) + s_cs * 8, ring + buf * (NSUB * 16384) + sub * 16384 + 8192 + tid * 16);
                }
            };
            {
            const int tid = opaque_tid();
            const int s_cs = tid & 3, c_key = tid >> 2, c_kc = s_cs ^ ((c_key >> 2) & 3);
#pragma unroll
            for (int part = 0; part < 2; ++part) {
                glds16(KCb + ((size_t)bh * 128 + c_key) * 64 + part * 32 + c_kc * 8, kcl + part * 8192 + tid * 16);
                glds16(VCb + ((size_t)bh * 128 + c_key) * 64 + part * 32 + s_cs * 8, vcl + part * 8192 + tid * 16);
            }
            }
            stage_kv(0, 0);
            bf16x8 Qf[4];
#pragma unroll
            for (int ks = 0; ks < 4; ++ks) Qf[ks] = *(const bf16x8*)(zrow + ZC_Q + hq * 64 + 16 * ks + 8 * h);
            float nmb;
            { float qq = 0.f;
#pragma unroll
              for (int ks = 0; ks < 4; ++ks)
#pragma unroll
                  for (int e = 0; e < 8; ++e) { const float qv = bf2f((bf16_t)Qf[ks][e]); qq += qv * qv; }
              qq += xshfl(qq, 32);
              nmb = -sqrtf(qq) * kbound; }
            const f32x16 cinit = {nmb, nmb, nmb, nmb, nmb, nmb, nmb, nmb, nmb, nmb, nmb, nmb, nmb, nmb, nmb, nmb};
            const float g0 = sigmoidf_(bf2f(zrow[ZC_NG + hq * 3])), g1 = sigmoidf_(bf2f(zrow[ZC_NG + hq * 3 + 1])), g2 = sigmoidf_(bf2f(zrow[ZC_NG + hq * 3 + 2]));
            asm volatile("s_waitcnt vmcnt(0)" ::: "memory");
            __syncthreads();
            unsigned resp[2][8];
            unsigned selmask;
            {
                f32x16 sc[4];
#pragma unroll
                for (int kt = 0; kt < 4; ++kt) {
                    sc[kt] = cinit;
#pragma unroll
                    for (int ks = 0; ks < 4; ++ks) {
                        const bf16x8 kf = *(const bf16x8*)(kcl + (ks >> 1) * 8192 + (32 * kt + r) * 64 + ((ks & 1) ? ksl1 : ksl0));
                        sc[kt] = __builtin_amdgcn_mfma_f32_32x32x16_bf16(kf, Qf[ks], sc[kt], 0, 0, 0);
                    }
                }
                const int ncv = tok >= 31 ? ((tok - 31) >> 4) + 1 : 0;
                const int cb = ncv - 4 * h;
                float sum = 0.f;
#pragma unroll
                for (int kt = 0; kt < 4; ++kt)
#pragma unroll
                    for (int reg = 0; reg < 16; ++reg) { const float pv = (32 * kt + KK(reg) < cb) ? __builtin_amdgcn_exp2f(sc[kt][reg]) : 0.f; sc[kt][reg] = pv; sum += pv; }
                sum += xshfl(sum, 32);
                const float inv = sum > 0.f ? 1.f / sum : 0.f;
#pragma unroll
                for (int kt = 0; kt < 4; ++kt) sc[kt] = sc[kt] * inv;
                f32x16 oc[2]; oc[0] = ZERO16_LIT; oc[1] = ZERO16_LIT;
#pragma unroll
                for (int sp = 0; sp < 8; ++sp) {
                    const bf16x8 pf = pack8(sc[sp >> 1], 8 * (sp & 1));
#pragma unroll
                    for (int dt = 0; dt < 2; ++dt) {
                        const bf16x8 vf = tr_read2(vcl + dt * 8192 + 16 * sp * 64 + vlo);
                        oc[dt] = __builtin_amdgcn_mfma_f32_32x32x16_bf16(vf, pf, oc[dt], 0, 0, 0);
                    }
                }
#pragma unroll
                for (int dt = 0; dt < 2; ++dt)
#pragma unroll
                    for (int q = 0; q < 8; ++q) resp[dt][q] = pk2(oc[dt][2 * q] * g0, oc[dt][2 * q + 1] * g0);
                float imp[16], lastv[16];
#pragma unroll
                for (int i = 0; i < 16; ++i) { const int kt = i >> 2, q = i & 3; imp[i] = (sc[kt][4 * q] + sc[kt][4 * q + 1]) + (sc[kt][4 * q + 2] + sc[kt][4 * q + 3]); lastv[i] = sc[kt][4 * q + 3]; }
                {
                    float recv[16];
#pragma unroll
                    for (int i = 0; i < 16; ++i) recv[i] = xshfl(lastv[i], 32);
#pragma unroll
                    for (int i = 0; i < 16; ++i) { const float pl = i >= 1 ? recv[i - 1] : 0.f; imp[i] += h ? recv[i] : pl; }
                }
#pragma unroll
                for (int i = 0; i < 16; ++i) { imp[i] += xshfl(imp[i], 1); imp[i] += xshfl(imp[i], 2); }
#pragma unroll
                for (int i = 0; i < 16; ++i) { const int j = 2 * i + h; imp[i] = (j == 0 || j == a || j == a - 1) ? __builtin_inff() : (j > a ? -__builtin_inff() : imp[i]); }
                float* itab = (float*)(lds + 98304) + (8 * wid + (r >> 2)) * 32;
                if (g == 0) {
#pragma unroll
                    for (int i = 0; i < 16; ++i) itab[2 * i + h] = imp[i];
                }
                asm volatile("s_waitcnt lgkmcnt(0)" ::: "memory");
                const int sub = g + 4 * h;
                const f32x4 mine = *(const f32x4*)(itab + 4 * sub);
                int rk0 = 0, rk1 = 0, rk2 = 0, rk3 = 0;
#pragma unroll
                for (int m4 = 0; m4 < 8; ++m4) {
                    const f32x4 vv = *(const f32x4*)(itab + 4 * m4);
#pragma unroll
                    for (int e = 0; e < 4; ++e) {
                        const float vm = vv[e]; const int mi = 4 * m4 + e;
                        rk0 += (int)(vm > mine[0]) | ((int)(vm == mine[0]) & (int)(mi < 4 * sub + 0));
                        rk1 += (int)(vm > mine[1]) | ((int)(vm == mine[1]) & (int)(mi < 4 * sub + 1));
                        rk2 += (int)(vm > mine[2]) | ((int)(vm == mine[2]) & (int)(mi < 4 * sub + 2));
                        rk3 += (int)(vm > mine[3]) | ((int)(vm == mine[3]) & (int)(mi < 4 * sub + 3));
                    }
                }
                unsigned mm = ((rk0 < 16 ? 1u : 0u) | (rk1 < 16 ? 2u : 0u) | (rk2 < 16 ? 4u : 0u) | (rk3 < 16 ? 8u : 0u)) << (4 * sub);
                mm |= (unsigned)xshfl_i((int)mm, 1); mm |= (unsigned)xshfl_i((int)mm, 2);
                selmask = mm | (unsigned)xshfl_i((int)mm, 32);
            }
            f32x16 O[2]; O[0] = ZERO16_FZ; O[1] = ZERO16_FZ;
            float lpart = fz;
#if PROBE_INNER
            unsigned long long pq_acc = 0ull;
#define PSTAMP(var) __builtin_amdgcn_sched_barrier(0); const unsigned long long var = __builtin_amdgcn_s_memrealtime(); __builtin_amdgcn_sched_barrier(0)
#else
#define PSTAMP(var)
#endif
#pragma unroll 1
            for (int st = 0; st < nsteps; ++st) {
                PSTAMP(ts0);
                asm volatile("s_waitcnt vmcnt(0)" ::: "memory");
                __syncthreads();
                if (st + 1 < nsteps) stage_kv(st + 1, (st + 1) & 1);
                PSTAMP(ts1);
                const bool slc = st < nslc; const int jb = slc ? NSUB * st : jw0 + NSUB * (st - nslc);
                const unsigned char* tb = ring + (st & 1) * (NSUB * 16384);
                f32x16 sc[2 * NSUB];
#pragma unroll
                for (int kt = 0; kt < 2 * NSUB; ++kt) {
                    const unsigned char* kb = tb + (kt >> 1) * 16384;
                    bf16x8 kf[4];
#pragma unroll
                    for (int ks = 0; ks < 4; ++ks) kf[ks] = *(const bf16x8*)(kb + (ks >> 1) * 4096 + (32 * (kt & 1) + r) * 64 + ((ks & 1) ? ksl1 : ksl0));
                    sc[kt] = cinit;
#pragma unroll
                    for (int ks = 0; ks < 4; ++ks) sc[kt] = __builtin_amdgcn_mfma_f32_32x32x16_bf16(kf[ks], Qf[ks], sc[kt], 0, 0, 0);
                }
                PSTAMP(ts2);
                float ps = 0.f;
#pragma unroll
                for (int sub = 0; sub < NSUB; ++sub) {
                    const int j = jb + sub;
                    const bool jvalid = j <= a;
                    const bool rowok = jvalid && (slc ? ((selmask >> (j & 31)) & 1u) != 0u : true);
                    bool full;
                    if (slc) full = (j < a) && __all(rowok);
                    else { const int tmin = t0 + 8 * wid; full = jvalid && (64 * j + 63 <= tmin) && (64 * j >= tmin + 7 - 511); }
                    if (full) {
#pragma unroll
                        for (int k2 = 0; k2 < 2; ++k2)
#pragma unroll
                            for (int reg = 0; reg < 16; ++reg) { const float pv = __builtin_amdgcn_exp2f(sc[2 * sub + k2][reg]); sc[2 * sub + k2][reg] = pv; ps += pv; }
                    } else {
                        const int base = tok - 64 * j - 4 * h;
                        const unsigned range = rowok ? (slc ? 0x80000000u : 512u) : 0u;
#pragma unroll
                        for (int k2 = 0; k2 < 2; ++k2)
#pragma unroll
                            for (int reg = 0; reg < 16; ++reg) {
                                const float pv = ((unsigned)(base - (32 * k2 + KK(reg))) < range) ? __builtin_amdgcn_exp2f(sc[2 * sub + k2][reg]) : 0.f;
                                sc[2 * sub + k2][reg] = pv; ps += pv;
                            }
                    }
                }
                lpart += ps;
                PSTAMP(ts3);
#pragma unroll
                for (int sub = 0; sub < NSUB; ++sub) {
                    const unsigned vaddr = (unsigned)(size_t)(tb + sub * 16384 + 8192 + vlo);
#pragma unroll
                    for (int sp2 = 0; sp2 < 2; ++sp2) {
                        bf16x8 vf[2][2];
                        if (sp2 == 0) TR8(vaddr, 0, vf); else TR8(vaddr, 2048, vf);
                        __builtin_amdgcn_sched_barrier(0);
#pragma unroll
                        for (int s2 = 0; s2 < 2; ++s2) {
                            const int sp = sp2 * 2 + s2;
                            const bf16x8 pf = pack8(sc[2 * sub + (sp >> 1)], 8 * (sp & 1));
#pragma unroll
                            for (int dt = 0; dt < 2; ++dt) O[dt] = __builtin_amdgcn_mfma_f32_32x32x16_bf16(vf[dt][s2], pf, O[dt], 0, 0, 0);
                        }
                    }
                }
                PSTAMP(ts4);
#if PROBE_INNER
                pq_acc += ((PROBE_INNER >> 12) & 1) * (ts1 - ts0) + ((PROBE_INNER >> 13) & 1) * (ts2 - ts1) + ((PROBE_INNER >> 14) & 1) * (ts3 - ts2) + ((PROBE_INNER >> 15) & 1) * (ts4 - ts3);
#endif
                if (st == nslc - 1 || st == nsteps - 1) {
                    const float lt = lpart + xshfl(lpart, 32);
                    const float gsc = (st == nslc - 1 ? g1 : g2) / lt;
#pragma unroll
                    for (int dt = 0; dt < 2; ++dt)
#pragma unroll
                        for (int q = 0; q < 8; ++q)
                            resp[dt][q] = pk2(__uint_as_float(resp[dt][q] << 16) + O[dt][2 * q] * gsc, __uint_as_float(resp[dt][q] & 0xffff0000u) + O[dt][2 * q + 1] * gsc);
                    O[0] = ZERO16_FZ; O[1] = ZERO16_FZ; lpart = fz;
                }
            }
#if PROBE_INNER
            if (opaque_tid() == 0) { volatile unsigned* w = (volatile unsigned*)(lds + LDS_CTL + 32); *w = *w + (unsigned)pq_acc; }
#endif
            bf16_t* orow = OA + (size_t)(b * SEQ + tok) * 512 + hq * 64 + 4 * h;
#pragma unroll
            for (int dt = 0; dt < 2; ++dt)
#pragma unroll
                for (int q = 0; q < 4; ++q) {
                    uint2 w; w.x = resp[dt][2 * q]; w.y = resp[dt][2 * q + 1];
                    *(uint2*)(orow + 32 * dt + 8 * q) = w;
                }
            __syncthreads();
        }
    }
    (void)l;
}

DEVFI void stage_glu(KP p, int l, unsigned char* lds) {
    unsigned char* ws = p->ws;
    const bf16_t* YB = (const bf16_t*)(ws + WS_YB);
    const bf16_t* G = (const bf16_t*)(ws + WS_GLU) + (size_t)l * 512 * 256;
    bf16_t* OB = (bf16_t*)(ws + WS_OB);
    for (int u = blockIdx.x; u < 64 * 2; u += gridDim.x) {
        const int tid = opaque_tid();
        const int mt = u >> 1, nt = u & 1;
        const bf16_t* a0 = YB + (size_t)(mt * 256 + (tid >> 2)) * 256 + SWZ_CHUNK(tid);
        const int brow = tid >> 2, sub = brow >> 4;
        const bf16_t* b0 = G + (size_t)((sub & 1) * 256 + nt * 128 + (sub >> 1) * 16 + (brow & 15)) * 256 + SWZ_CHUNK(tid);
        const bf16_t* b1 = G + (size_t)((sub & 1) * 256 + nt * 128 + ((sub + 8) >> 1) * 16 + (brow & 15)) * 256 + SWZ_CHUNK(tid);
        f32x4 acc[8][4];
        gemm_tile8<4>(lds, a0, a0 + (size_t)128 * 256, b0, b1, 8, acc);
        const int tid2 = opaque_tid(), lane2 = tid2 & 63, wid2 = tid2 >> 6, wr = wid2 >> 2, wc = wid2 & 3, fr = lane2 & 15, fq = lane2 >> 4;
#pragma unroll
        for (int m = 0; m < 8; ++m)
#pragma unroll
            for (int n = 0; n < 4; n += 2) {
                const int row = mt * 256 + wr * 128 + m * 16 + fr, col = nt * 128 + (wc * 2 + (n >> 1)) * 16 + fq * 4;
                float o[4];
#pragma unroll
                for (int r = 0; r < 4; ++r) o[r] = acc[m][n][r] * sigmoidf_(acc[m][n + 1][r]);
                uint2 w; w.x = pk2(o[0], o[1]); w.y = pk2(o[2], o[3]);
                *(uint2*)(OB + (size_t)row * 256 + col) = w;
            }
    }
}

DEVFI void stage_merge(KP p, int l, unsigned char* lds) {
    unsigned char* ws = p->ws;
    const bf16_t* OA = (const bf16_t*)(ws + WS_OA); const bf16_t* OB = (const bf16_t*)(ws + WS_OB);
    const bf16_t* PA = (const bf16_t*)(ws + WS_PA) + (size_t)l * 1024 * 512; const bf16_t* PS = (const bf16_t*)(ws + WS_PS) + (size_t)l * 1024 * 256;
    const bf16_t* Z = (const bf16_t*)(ws + WS_Z);
    bf16_t* MRG = (bf16_t*)(ws + WS_MRG);
    for (int u = blockIdx.x; u < 64 * 8; u += gridDim.x) {
        const int mt = u & 63, nt = u >> 6;
        f32x4 acc1[8][2], acc2[8][2];
        {
            const int tid = opaque_tid();
            const bf16_t* a0 = OA + (size_t)(mt * 256 + (tid >> 2)) * 512 + SWZ_CHUNK(tid);
            const bf16_t* b0 = PA + (size_t)(nt * 128 + (tid >> 2)) * 512 + SWZ_CHUNK(tid);
            gemm_tile8<2>(lds, a0, a0 + (size_t)128 * 512, b0, nullptr, 16, acc1);
        }
        {
            const int tid = opaque_tid();
            const bf16_t* a0 = OB + (size_t)(mt * 256 + (tid >> 2)) * 256 + SWZ_CHUNK(tid);
            const bf16_t* b0 = PS + (size_t)(nt * 128 + (tid >> 2)) * 256 + SWZ_CHUNK(tid);
            gemm_tile8<2>(lds, a0, a0 + (size_t)128 * 256, b0, nullptr, 8, acc2);
        }
        const int tid2 = opaque_tid(), lane2 = tid2 & 63, wid2 = tid2 >> 6, wr = wid2 >> 2, wc = wid2 & 3, fr = lane2 & 15, fq = lane2 >> 4;
#pragma unroll
        for (int m = 0; m < 8; ++m)
#pragma unroll
            for (int n = 0; n < 2; ++n) {
                const int row = mt * 256 + wr * 128 + m * 16 + fr, col = nt * 128 + wc * 32 + n * 16 + fq * 4;
                const uint2 ga = *(const uint2*)(Z + (size_t)row * ZN + ZC_GA + col), gs = *(const uint2*)(Z + (size_t)row * ZN + ZC_GS + col);
                float o[4];
                o[0] = sigmoidf_(__uint_as_float(ga.x << 16)) * acc1[m][n][0] + sigmoidf_(__uint_as_float(gs.x << 16)) * acc2[m][n][0];
                o[1] = sigmoidf_(__uint_as_float(ga.x & 0xffff0000u)) * acc1[m][n][1] + sigmoidf_(__uint_as_float(gs.x & 0xffff0000u)) * acc2[m][n][1];
                o[2] = sigmoidf_(__uint_as_float(ga.y << 16)) * acc1[m][n][2] + sigmoidf_(__uint_as_float(gs.y << 16)) * acc2[m][n][2];
                o[3] = sigmoidf_(__uint_as_float(ga.y & 0xffff0000u)) * acc1[m][n][3] + sigmoidf_(__uint_as_float(gs.y & 0xffff0000u)) * acc2[m][n][3];
                uint2 w; w.x = pk2(o[0], o[1]); w.y = pk2(o[2], o[3]);
                *(uint2*)(MRG + (size_t)row * 1024 + col) = w;
            }
    }
}

struct OutSched {
    const char* A; const char* B; int G, c;
    DEVFI bool next(int i, pg8::Unit& u) const {
        const int v = c + i * G; if (v >= 64 * 4) return false;
        int mt, nt; xcd_order(v, 64, 4, mt, nt);
        u.a = A + (size_t)mt * 256 * 1024 * 2; u.b = B + (size_t)nt * 256 * 1024 * 2; u.r0 = mt * 256; u.c0 = nt * 256; u.x0 = 0; u.x1 = 0;
        return true;
    }
};
struct OutEpi {
    float* X;
    DEVFI void operator()(const f32x4 (&acc)[2][2][4][2], const pg8::Unit& u, int wr, int wc, int fr, int fq) const {
#pragma unroll
        for (int ai = 0; ai < 2; ++ai)
#pragma unroll
            for (int m = 0; m < 4; ++m) {
                float* xp = X + (size_t)(u.r0 + ai * 128 + wr * 64 + m * 16 + fr) * 1024 + u.c0 + wc * 32 + fq * 4;
#pragma unroll
                for (int bj = 0; bj < 2; ++bj)
#pragma unroll
                    for (int n = 0; n < 2; ++n) { float* q = xp + bj * 128 + n * 16; *(f32x4*)q = *(const f32x4*)q + acc[ai][bj][m][n]; }
            }
    }
};
DEVFI void stage_out(KP p, int l, unsigned char* lds) {
    unsigned char* ws = p->ws;
    OutSched S{(const char*)(ws + WS_MRG), (const char*)(ws + WS_WO) + (size_t)l * 1024 * 1024 * 2, (int)gridDim.x, (int)blockIdx.x};
    OutEpi E{p->out};
    pg8::gemm_phase(lds, 1024, S, E);
}

DEVFI void stage_route(KP p, int l, unsigned char* lds) {
    const int tid = opaque_tid(), lane = tid & 63, wid = tid >> 6, j = lane & 15, kq = lane >> 4;
    unsigned char* ws = p->ws;
    const float* xres = p->out;
    bf16_t* XB = (bf16_t*)(ws + WS_H);
    float* RS = (float*)(ws + WS_RSTD) + NTOK;
    const float* WRT = (const float*)(ws + WS_WRT) + (size_t)l * 48 * 1024;
    const float* brg = (const float*)p->in[26] + l * 4; const float* bre = (const float*)p->in[28] + l * 32;
    int* cnt = (int*)(ws + CTL_CNT) + l * 32;
    int* eid = (int*)(ws + WS_EID); float* ew = (float*)(ws + WS_EW); int* epos = (int*)(ws + WS_EPOS); int* list = (int*)(ws + WS_LIST);
    float* part = (float*)lds;
    float* pss = part + 8 * 16 * 52;
    float* tot = pss + 128;
    int* lcnt = (int*)(tot + 16 * 52);
    int* lbase = lcnt + 32;
    int* lsel = lbase + 32;
    constexpr int MAXG = 8;
    f32x4 wf[3][4][2];
#pragma unroll
    for (int t = 0; t < 3; ++t)
#pragma unroll
        for (int S = 0; S < 4; ++S) {
            wf[t][S][0] = *(const f32x4*)(WRT + (size_t)(16 * t + j) * 1024 + 128 * wid + 32 * S + 8 * kq);
            wf[t][S][1] = *(const f32x4*)(WRT + (size_t)(16 * t + j) * 1024 + 128 * wid + 32 * S + 8 * kq + 4);
        }
    if (tid < 32) lcnt[tid] = 0;
    __syncthreads();
    int ng = 0, grp0 = blockIdx.x;
    for (int grp = blockIdx.x; grp < NTOK / 16; grp += gridDim.x) {
        const int tok = grp * 16 + j;
        const float* xp = xres + (size_t)tok * 1024 + 128 * wid + 8 * kq;
        bf16_t* xbp = XB + (size_t)tok * 1024 + 128 * wid + 8 * kq;
        f32x4 xv[4][2];
#pragma unroll
        for (int S = 0; S < 4; ++S) { xv[S][0] = *(const f32x4*)(xp + 32 * S); xv[S][1] = *(const f32x4*)(xp + 32 * S + 4); }
        f32x4 acc[3] = {{0.f, 0.f, 0.f, 0.f}, {0.f, 0.f, 0.f, 0.f}, {0.f, 0.f, 0.f, 0.f}};
        float ss = 0.f;
#pragma unroll
        for (int S = 0; S < 4; ++S) {
            uint4 o;
            o.x = pk2(xv[S][0][0], xv[S][0][1]); o.y = pk2(xv[S][0][2], xv[S][0][3]); o.z = pk2(xv[S][1][0], xv[S][1][1]); o.w = pk2(xv[S][1][2], xv[S][1][3]);
            *(uint4*)(xbp + 32 * S) = o;
#pragma unroll
            for (int hh = 0; hh < 2; ++hh) {
                ss += xv[S][hh][0] * xv[S][hh][0] + xv[S][hh][1] * xv[S][hh][1] + xv[S][hh][2] * xv[S][hh][2] + xv[S][hh][3] * xv[S][hh][3];
#pragma unroll
                for (int e = 0; e < 4; ++e) {
                    acc[0] = __builtin_amdgcn_mfma_f32_16x16x4f32(wf[0][S][hh][e], xv[S][hh][e], acc[0], 0, 0, 0);
                    acc[1] = __builtin_amdgcn_mfma_f32_16x16x4f32(wf[1][S][hh][e], xv[S][hh][e], acc[1], 0, 0, 0);
                    acc[2] = __builtin_amdgcn_mfma_f32_16x16x4f32(wf[2][S][hh][e], xv[S][hh][e], acc[2], 0, 0, 0);
                }
            }
        }
        ss += xshfl(ss, 16); ss += xshfl(ss, 32);
#pragma unroll
        for (int t = 0; t < 3; ++t) *(f32x4*)(part + (wid * 16 + j) * 52 + t * 16 + kq * 4) = acc[t];
        if (kq == 0) pss[wid * 16 + j] = ss;
        __syncthreads();
        if (tid < 192) {
            const int jj = tid & 15, c = tid >> 4;
            f32x4 sm = *(const f32x4*)(part + jj * 52 + 4 * c);
#pragma unroll
            for (int w = 1; w < 8; ++w) sm = sm + *(const f32x4*)(part + (w * 16 + jj) * 52 + 4 * c);
            *(f32x4*)(tot + jj * 52 + 4 * c) = sm;
            if (c == 0) { float st = 0.f;
#pragma unroll
                for (int w = 0; w < 8; ++w) st += pss[w * 16 + jj];
                tot[jj * 52 + 48] = st; }
        }
        __syncthreads();
        if (tid < 16) {
            const int tk = grp * 16 + tid;
            const float rstd = rsqrtf(tot[tid * 52 + 48] * (1.f / 1024.f) + RMS_EPS);
            RS[tk] = rstd;
            const float* lt = tot + tid * 52;
            float gl[4];
#pragma unroll
            for (int i = 0; i < 4; ++i) gl[i] = lt[i] * rstd + brg[i];
            int gs = 0; float gm = gl[0];
#pragma unroll
            for (int i = 1; i < 4; ++i) if (gl[i] > gm) { gm = gl[i]; gs = i; }
            float gsum = 0.f;
#pragma unroll
            for (int i = 0; i < 4; ++i) gsum += __expf(gl[i] - gm);
            const float gwt = 1.f / gsum;
            float el[8];
            { const f32x4 a = *(const f32x4*)(lt + 4 + gs * 8), bq = *(const f32x4*)(lt + 8 + gs * 8);
              const f32x4 ba = *(const f32x4*)(bre + gs * 8), bb = *(const f32x4*)(bre + gs * 8 + 4);
              el[0] = a[0] * rstd + ba[0]; el[1] = a[1] * rstd + ba[1]; el[2] = a[2] * rstd + ba[2]; el[3] = a[3] * rstd + ba[3];
              el[4] = bq[0] * rstd + bb[0]; el[5] = bq[1] * rstd + bb[1]; el[6] = bq[2] * rstd + bb[2]; el[7] = bq[3] * rstd + bb[3]; }
            int i1 = 0; float m1 = el[0];
#pragma unroll
            for (int i = 1; i < 8; ++i) if (el[i] > m1) { m1 = el[i]; i1 = i; }
            int i2 = -1; float m2 = -__builtin_inff();
#pragma unroll
            for (int i = 0; i < 8; ++i) if (i != i1 && el[i] > m2) { m2 = el[i]; i2 = i; }
            const float e2 = __expf(m2 - m1);
            const float w1 = gwt / (1.f + e2), w2 = gwt * e2 / (1.f + e2);
            const int ea = gs * 8 + i1, eb = gs * 8 + i2;
            eid[tk * 2] = ea; eid[tk * 2 + 1] = eb; ew[tk * 2] = w1; ew[tk * 2 + 1] = w2;
            int* sl = lsel + (ng * 16 + tid) * 4;
            sl[0] = ea; sl[1] = eb; sl[2] = atomicAdd(lcnt + ea, 1); sl[3] = atomicAdd(lcnt + eb, 1);
        }
        ++ng;
        const bool last = grp + (int)gridDim.x >= NTOK / 16;
        if (ng == MAXG || last) {
            __syncthreads();
            if (tid < 32) { const int c = lcnt[tid]; lbase[tid] = c ? atomicAdd(cnt + tid, c) : 0; }
            __syncthreads();
            if (tid < ng * 16) {
                const int tk = (grp0 + (tid >> 4) * (int)gridDim.x) * 16 + (tid & 15);
                const int* sl = lsel + tid * 4;
                const int ea = sl[0], eb = sl[1], pa = lbase[ea] + sl[2], pb = lbase[eb] + sl[3];
                epos[tk * 2] = pa; epos[tk * 2 + 1] = pb;
                list[ea * NTOK + pa] = tk; list[eb * NTOK + pb] = tk;
            }
            __syncthreads();
            if (tid < 32) lcnt[tid] = 0;
            ng = 0; grp0 = grp + (int)gridDim.x;
            __syncthreads();
        }
    }
}

DEVFI bool find_tile(const int* cnt, int ti, int& e, int& mt, int& segstart, int& ecnt) {
    int acc_t = 0, acc_s = 0;
    for (int i = 0; i < 32; ++i) {
        const int c = __builtin_amdgcn_readfirstlane(cnt[i]), nt = (c + 255) >> 8;
        if (ti < acc_t + nt) { e = i; mt = __builtin_amdgcn_readfirstlane(ti - acc_t); segstart = __builtin_amdgcn_readfirstlane(acc_s); ecnt = __builtin_amdgcn_readfirstlane(c); return true; }
        acc_t += nt; acc_s += nt << 8;
    }
    return false;
}

struct GateupSched {
    const char* XB; const char* B; const int* cnt; const int* list; int G, c;
    DEVFI bool next(int i, pg8::Unit& u) const {
        const int v = c + i * G, ti = (v & 7) + 8 * (v >> 5), nt = (v >> 3) & 3;
        int e, mt, seg, ec;
        if (!find_tile(cnt, ti, e, mt, seg, ec)) return false;
        u.a = nullptr; u.b = B + ((size_t)e * 1024 + nt * 256) * 1024 * 2; u.r0 = seg + mt * 256; u.c0 = nt * 128; u.x0 = e * NTOK + mt * 256; u.x1 = ec - mt * 256;
        return true;
    }
    DEVFI const char* gather_base() const { return XB; }
    DEVFI void rows(const pg8::Unit& u, unsigned (&ap)[2][2]) const {
        const int tid = opaque_tid();
#pragma unroll
        for (int i = 0; i < 2; ++i) {
            int R, C; pg8::stage_rc(tid * 16 + i * 8192, R, C);
#pragma unroll
            for (int h = 0; h < 2; ++h) {
                const int rl = 128 * h + R;
                const int tk = list[u.x0 + (rl < u.x1 ? rl : 0)];
                ap[h][i] = (unsigned)(tk * 1024 + C) * 2u;
            }
        }
    }
};
struct GateupEpi {
    bf16_t* ACT; const float* RS; const int* list;
    DEVFI void operator()(const f32x4 (&acc)[2][2][4][2], const pg8::Unit& u, int wr, int wc, int fr, int fq) const {
#pragma unroll
        for (int ai = 0; ai < 2; ++ai)
#pragma unroll
            for (int m = 0; m < 4; ++m) {
                const int rl = ai * 128 + wr * 64 + m * 16 + fr;
                const float rs = RS[list[u.x0 + (rl < u.x1 ? rl : 0)]];
                bf16_t* ap = ACT + (size_t)(u.r0 + rl) * 512 + u.c0 + wc * 16 + fq * 4;
#pragma unroll
                for (int bj = 0; bj < 2; ++bj) {
                    float o[4];
#pragma unroll
                    for (int r = 0; r < 4; ++r) { const float g = acc[ai][bj][m][0][r] * rs; o[r] = g * sigmoidf_(g) * (acc[ai][bj][m][1][r] * rs); }
                    uint2 w; w.x = pk2(o[0], o[1]); w.y = pk2(o[2], o[3]);
                    *(uint2*)(ap + bj * 64) = w;
                }
            }
    }
};
DEVFI void stage_gateup(KP p, int l, unsigned char* lds) {
    unsigned char* ws = p->ws;
    const int* cnt = (const int*)(ws + CTL_CNT) + l * 32;
    const int* list = (const int*)(ws + WS_LIST);
    GateupSched S{(const char*)(ws + WS_H), (const char*)(ws + WS_EG) + (size_t)l * 32 * 1024 * 1024 * 2, cnt, list, (int)gridDim.x, (int)blockIdx.x};
    GateupEpi E{(bf16_t*)(ws + WS_ACT), (const float*)(ws + WS_RSTD) + NTOK, list};
    pg8::gemm_phase<GateupEpi, GateupSched, true>(lds, 1024, S, E);
}

struct DownSched {
    const char* A; const char* B; const int* cnt; int G, c;
    DEVFI bool next(int i, pg8::Unit& u) const {
        const int v = c + i * G, ti = (v & 7) + 8 * (v >> 5), nt = (v >> 3) & 3;
        int e, mt, seg, ec;
        if (!find_tile(cnt, ti, e, mt, seg, ec)) return false;
        u.a = A + (size_t)(seg + mt * 256) * 512 * 2; u.b = B + ((size_t)e * 1024 + nt * 256) * 512 * 2; u.r0 = seg + mt * 256; u.c0 = nt * 256; u.x0 = 0; u.x1 = 0;
        return true;
    }
};
struct DownEpi {
    bf16_t* Y;
    DEVFI void operator()(const f32x4 (&acc)[2][2][4][2], const pg8::Unit& u, int wr, int wc, int fr, int fq) const {
#pragma unroll
        for (int ai = 0; ai < 2; ++ai)
#pragma unroll
            for (int m = 0; m < 4; ++m) {
                bf16_t* yp = Y + (size_t)(u.r0 + ai * 128 + wr * 64 + m * 16 + fr) * 1024 + u.c0 + wc * 32 + fq * 4;
#pragma unroll
                for (int bj = 0; bj < 2; ++bj)
#pragma unroll
                    for (int n = 0; n < 2; ++n) {
                        const f32x4 v = acc[ai][bj][m][n];
                        uint2 o; o.x = pk2(v[0], v[1]); o.y = pk2(v[2], v[3]);
                        *(uint2*)(yp + bj * 128 + n * 16) = o;
                    }
            }
    }
};
DEVFI void stage_down(KP p, int l, unsigned char* lds) {
    unsigned char* ws = p->ws;
    DownSched S{(const char*)(ws + WS_ACT), (const char*)(ws + WS_ED) + (size_t)l * 32 * 1024 * 512 * 2, (const int*)(ws + CTL_CNT) + l * 32, (int)gridDim.x, (int)blockIdx.x};
    DownEpi E{(bf16_t*)(ws + WS_Y)};
    pg8::gemm_phase(lds, 512, S, E);
}

__global__ void __launch_bounds__(512) mega(Params p0) {
    extern __shared__ __attribute__((aligned(16))) unsigned char lds[];
    volatile LAS unsigned* ctl = (volatile LAS unsigned*)(LAS unsigned char*)(lds + LDS_CTL);
    if (threadIdx.x < 64) ctl[threadIdx.x] = 0u;
    if ((threadIdx.x & 63) == 0) *(volatile LAS int*)(LAS unsigned char*)(unsigned)(LDS_WVTAB_ADDR + 4 * hw_wave_slot()) = (int)(threadIdx.x >> 6);
    __syncthreads();
    XcdBarrier bar; bar.bar = (unsigned*)p0.ws; bar.x = 0; bar.st = ctl;
    const bool multi = (p0.ph_hi - p0.ph_lo) > 1;
    if (multi) bar = xcd_barrier_post((unsigned*)p0.ws, ctl);
#if PROBE_MASK || PROBE_INNER
    unsigned long long pr_prev = __builtin_amdgcn_s_memrealtime(), pr_acc = 0ull;
#endif
    for (int ph = p0.ph_lo; ph < p0.ph_hi; ++ph) {
        KP p = (KP)__builtin_amdgcn_kernarg_segment_ptr();
#if PROBE_INNER
        { const int kind_ = ph < NPRE ? ph : (ph == NPHASE - 1 ? 11 : 2 + (ph - NPRE) % NST);
          if (opaque_tid() == 0) *(volatile unsigned*)(lds + LDS_CTL + 36) = (PROBE_INNER >> kind_) & 1; }
        __syncthreads();
#endif
        asm volatile("" : "+s"(p));
#ifndef ONLY
#define ONLY -1
#endif
#ifndef SKIP
#define SKIP -1
#endif
#define RUN(k) ((ONLY < 0 || ONLY == (k)) && SKIP != (k))
        if (ph == 0) { if (RUN(100)) phase_prep(p, lds); }
        else if (ph == 1) { if (RUN(101)) phase_prep1(p); }
        else if (ph == NPHASE - 1) { if (RUN(0)) stage_norm1(p, DEPTH, true); }
        else {
            const int l = (ph - NPRE) / NST, s = (ph - NPRE) % NST;
            switch (s) {
                case 0: if (RUN(0)) stage_norm1(p, l, false); break;
                case 1: if (RUN(1)) stage_inproj(p, l, lds); break;
                case 2: if (RUN(2)) stage_posta(p, l, lds); break;
                case 3: if (RUN(4)) {
#if PROBE_INNER
                    const unsigned long long pa_t0 = __builtin_amdgcn_s_memrealtime();
#endif
                    stage_attn(p, l, lds);
#if PROBE_INNER
                    if ((PROBE_INNER >> 5) & 1) { __syncthreads(); if (opaque_tid() == 0) { volatile unsigned* w = (volatile unsigned*)(lds + LDS_CTL + 32); *w = *w + (unsigned)(__builtin_amdgcn_s_memrealtime() - pa_t0); } }
#endif
                    stage_glu(p, l, lds); } break;
                case 4: if (RUN(6)) stage_merge(p, l, lds); break;
                case 5: if (RUN(7)) stage_out(p, l, lds); break;
                case 6: if (RUN(8)) stage_route(p, l, lds); break;
                case 7: if (RUN(9)) stage_gateup(p, l, lds); break;
                default: if (RUN(10)) stage_down(p, l, lds); break;
            }
        }
        if (ph + 1 < p0.ph_hi) xcd_barrier(bar);
#if PROBE_MASK || PROBE_INNER
        {
            const int kind = ph < NPRE ? ph : (ph == NPHASE - 1 ? 11 : 2 + (ph - NPRE) % NST);
            const unsigned long long now = __builtin_amdgcn_s_memrealtime();
            if ((PROBE_MASK >> kind) & 1) pr_acc += now - pr_prev;
            pr_prev = now;
        }
#endif
    }
#if PROBE_MASK || PROBE_INNER
#if PROBE_INNER
    __syncthreads();
    pr_acc += *(volatile unsigned*)(lds + LDS_CTL + 32);
#endif
    if (blockIdx.x == 0) { const unsigned long long t0 = __builtin_amdgcn_s_memrealtime(); while (__builtin_amdgcn_s_memrealtime() - t0 < pr_acc) __builtin_amdgcn_s_sleep(8); }
#endif
}

extern "C" void kernel_launch(void* const* d_in, const int* in_sizes, int n_in, void* d_out, int out_size, void* d_ws, size_t ws_size, hipStream_t stream) {
    static int grid = 0;
    if (grid == 0) {
        if (n_in != 32 || out_size != NTOK * D || ws_size < WS_END) {
            fprintf(stderr, "kernel_launch: unexpected problem: n_in %d out %d ws %zu (need %zu)\n", n_in, out_size, ws_size, (size_t)WS_END);
            grid = -1; return;
        }
        int dev = 0, cus = 0, per_cu = 0;
        hipGetDevice(&dev);
        hipDeviceGetAttribute(&cus, hipDeviceAttributeMultiprocessorCount, dev);
        hipFuncSetAttribute((const void*)mega, hipFuncAttributeMaxDynamicSharedMemorySize, LDS_BYTES);
        hipOccupancyMaxActiveBlocksPerMultiprocessor(&per_cu, (const void*)mega, 512, LDS_BYTES);
        (void)hipGetLastError();
        if (per_cu < 1) { fprintf(stderr, "kernel_launch: occupancy query says %d blocks per CU\n", per_cu); grid = -1; return; }
        grid = cus;
    }
    if (grid < 0) return;
    hipMemsetAsync(d_ws, 0, CTL_BYTES, stream);
    Params p{};
    for (int i = 0; i < 32; ++i) p.in[i] = d_in[i];
    p.out = (float*)d_out; p.ws = (unsigned char*)d_ws;
#if MK_SPLIT
    for (int ph = 0; ph < NPHASE; ++ph) {
        p.ph_lo = ph; p.ph_hi = ph + 1;
        hipLaunchKernelGGL(mega, dim3(grid), dim3(512), LDS_BYTES, stream, p);
    }
#else
    p.ph_lo = 0; p.ph_hi = NPHASE;
    void* args[] = {&p};
    hipError_t e = hipLaunchCooperativeKernel((const void*)mega, dim3(grid), dim3(512), args, LDS_BYTES, stream);
    if (e != hipSuccess) fprintf(stderr, "kernel_launch: cooperative launch failed: %s (grid %d)\n", hipGetErrorString(e), grid);
#endif
    (void)in_sizes;
}
```
